# Optimizing an MI355X kernel written in HIP

```python
import math
import jax, jax.numpy as jnp
from jax import lax
import numpy as np

D_MODEL = 1024
BATCH = 4
SEQ = 4096
DEPTH = 1

MEM_LEN = 256
DA_HEADS = 8
DA_HEAD_DIM = 64
DA_QK = DA_HEADS * 2 * DA_HEAD_DIM
DA_V = DA_HEADS * 2 * DA_HEAD_DIM
Q_BLOCK = 128
SSD_EXPAND = 2
SSD_INNER = SSD_EXPAND * D_MODEL
SSD_HEAD_DIM = 64
SSD_HEADS = SSD_INNER // SSD_HEAD_DIM
SSD_GROUPS = 4
SSD_HEADS_PER_GROUP = SSD_HEADS // SSD_GROUPS
SSD_STATE = 128
SSD_CONV = 4
SSD_CHUNK = 128
SSD_CONV_DIM = SSD_INNER + 2 * SSD_GROUPS * SSD_STATE
XA_HEADS = 4
XA_HEAD_DIM = D_MODEL // XA_HEADS
D_FF = 2816
N_BRANCH = 2
IN_SIZES = (DA_QK, DA_QK, DA_V, SSD_INNER, SSD_CONV_DIM, SSD_HEADS, N_BRANCH * D_MODEL)
IN_WIDTH = DA_QK + DA_QK + DA_V + SSD_INNER + SSD_CONV_DIM + SSD_HEADS + N_BRANCH * D_MODEL
NORM_EPS = 1e-6
SUBLN_EPS = 1e-5

kernel_name = "hybrid_diffattn_ssd_gated_macaron"


def _rmsnorm(x, g, eps=NORM_EPS):
    xf = x.astype(jnp.float32)
    y = xf * lax.rsqrt(jnp.mean(xf * xf, axis=-1, keepdims=True) + eps)
    return (y * g.astype(jnp.float32)).astype(x.dtype)


def _swiglu(h, w_gu, w_down):
    g, u = jnp.split(h @ w_gu, 2, axis=-1)
    return (jax.nn.silu(g) * u) @ w_down


def _diff_attention(q, k, v, lam):
    b, s = q.shape[0], q.shape[1]
    q1, q2 = q[:, :, :, 0].transpose(0, 2, 1, 3), q[:, :, :, 1].transpose(0, 2, 1, 3)
    k1, k2 = k[:, :, :, 0].transpose(0, 2, 1, 3), k[:, :, :, 1].transpose(0, 2, 1, 3)
    vh = v.transpose(0, 2, 1, 3)
    nblk = s // Q_BLOCK
    scale = DA_HEAD_DIM ** -0.5
    key_pos = jnp.arange(s)

    def blocks(t):
        return t.reshape(b, DA_HEADS, nblk, Q_BLOCK, DA_HEAD_DIM).transpose(2, 0, 1, 3, 4)

    def one_block(args):
        q1b, q2b, start = args
        mask = (start + jnp.arange(Q_BLOCK))[:, None] >= key_pos[None, :]

        def probs(qb, kk):
            sc = jnp.einsum('bhqd,bhkd->bhqk', qb, kk).astype(jnp.float32) * scale
            return jax.nn.softmax(jnp.where(mask, sc, -jnp.inf), axis=-1)

        p = probs(q1b, k1) - lam * probs(q2b, k2)
        return jnp.einsum('bhqk,bhke->bhqe', p.astype(vh.dtype), vh)

    out = lax.map(one_block, (blocks(q1), blocks(q2), jnp.arange(nblk, dtype=jnp.int32) * Q_BLOCK))
    return out.transpose(1, 2, 0, 3, 4).reshape(b, DA_HEADS, s, 2 * DA_HEAD_DIM)


def _segsum(a):
    t = a.shape[-1]
    cs = jnp.cumsum(a, axis=-1)
    seg = cs[..., :, None] - cs[..., None, :]
    return jnp.where(jnp.tril(jnp.ones((t, t), dtype=bool)), seg, -jnp.inf)


def _ssd_chunked(xdt, adt, bm, cm):
    b, s = xdt.shape[0], xdt.shape[1]
    c = s // SSD_CHUNK
    G, R, P, N, Lc = SSD_GROUPS, SSD_HEADS_PER_GROUP, SSD_HEAD_DIM, SSD_STATE, SSD_CHUNK
    X = xdt.astype(jnp.float32).reshape(b, c, Lc, G, R, P)
    A = adt.astype(jnp.float32).reshape(b, c, Lc, G, R).transpose(0, 3, 4, 1, 2)
    Bc = bm.astype(jnp.float32).reshape(b, c, Lc, G, N)
    Cc = cm.astype(jnp.float32).reshape(b, c, Lc, G, N)
    a_cs = jnp.cumsum(A, axis=-1)
    Lmat = jnp.exp(_segsum(A))
    cb = jnp.einsum('bclgn,bcsgn->bgcls', Cc, Bc)
    y_diag = jnp.einsum('bgrcls,bcsgrp->bclgrp', cb[:, :, None] * Lmat, X)
    decay_states = jnp.exp(a_cs[..., -1:] - a_cs)
    states = jnp.einsum('bclgn,bgrcl,bclgrp->bcgrpn', Bc, decay_states, X)
    chunk_end = jnp.pad(a_cs[..., -1], ((0, 0), (0, 0), (0, 0), (1, 0)))
    decay_chunk = jnp.exp(_segsum(chunk_end))
    states = jnp.concatenate([jnp.zeros_like(states[:, :1]), states], axis=1)
    prev_states = jnp.einsum('bgrzc,bcgrpn->bzgrpn', decay_chunk, states)[:, :-1]
    y_off = jnp.einsum('bclgn,bcgrpn,bgrcl->bclgrp', Cc, prev_states, jnp.exp(a_cs))
    return (y_diag + y_off).reshape(b, s, SSD_HEADS, P)


def _depthwise_causal_conv(u, w, bias):
    y = lax.conv_general_dilated(u, w.astype(u.dtype)[:, None, :], window_strides=(1,),
                                 padding=[(SSD_CONV - 1, 0)],
                                 dimension_numbers=('NWC', 'WIO', 'NWC'),
                                 feature_group_count=u.shape[-1])
    return y + bias.astype(u.dtype)


def _layer(x, mem, layer_idx,
           ffn1_pre_g, ffn1_post_g, ffn1_w_gu, ffn1_w_down,
           mix_pre_g, mix_post_g, w_in, b_gate,
           da_lambda_q1, da_lambda_k1, da_lambda_q2, da_lambda_k2, da_subln_g,
           ssd_conv_w, ssd_conv_b, ssd_dt_bias, ssd_A_log, ssd_D, ssd_norm_g,
           w_branch_attn, w_branch_ssd, w_mix_out,
           xa_pre_g, xa_post_g, mem_norm_g, xa_w_q, xa_w_kv, xa_w_o,
           ffn2_pre_g, ffn2_post_g, ffn2_w_gu, ffn2_w_down):
    b, s, _ = x.shape
    x = x + 0.5 * _rmsnorm(_swiglu(_rmsnorm(x, ffn1_pre_g), ffn1_w_gu, ffn1_w_down), ffn1_post_g)

    h = _rmsnorm(x, mix_pre_g)
    cuts = [sum(IN_SIZES[:i + 1]) for i in range(len(IN_SIZES) - 1)]
    q, k, v, z, xbc, dt_raw, gate_logits = jnp.split(h @ w_in, cuts, axis=-1)

    lam_init = 0.8 - 0.6 * math.exp(-0.3 * layer_idx)
    lam = (jnp.exp(jnp.sum(da_lambda_q1 * da_lambda_k1).astype(jnp.float32))
           - jnp.exp(jnp.sum(da_lambda_q2 * da_lambda_k2).astype(jnp.float32)) + lam_init)
    o = _diff_attention(q.reshape(b, s, DA_HEADS, 2, DA_HEAD_DIM),
                        k.reshape(b, s, DA_HEADS, 2, DA_HEAD_DIM),
                        v.reshape(b, s, DA_HEADS, 2 * DA_HEAD_DIM), lam)
    o = _rmsnorm(o, da_subln_g, SUBLN_EPS) * (1.0 - lam_init)
    attn_out = o.transpose(0, 2, 1, 3).reshape(b, s, DA_V) @ w_branch_attn

    xbc = jax.nn.silu(_depthwise_causal_conv(xbc, ssd_conv_w, ssd_conv_b))
    xs, bm, cm = jnp.split(xbc, [SSD_INNER, SSD_INNER + SSD_GROUPS * SSD_STATE], axis=-1)
    dt = jax.nn.softplus(dt_raw.astype(jnp.float32) + ssd_dt_bias.astype(jnp.float32))
    a = -jnp.exp(ssd_A_log.astype(jnp.float32))
    xh = xs.reshape(b, s, SSD_HEADS, SSD_HEAD_DIM)
    y = _ssd_chunked(xh * dt[..., None], a * dt,
                     bm.reshape(b, s, SSD_GROUPS, SSD_STATE), cm.reshape(b, s, SSD_GROUPS, SSD_STATE))
    y = (y + ssd_D.astype(jnp.float32)[:, None] * xh).astype(x.dtype).reshape(b, s, SSD_INNER)
    yg = (y * jax.nn.silu(z)).reshape(b, s, SSD_GROUPS, SSD_INNER // SSD_GROUPS)
    y = _rmsnorm(yg, ssd_norm_g.reshape(SSD_GROUPS, SSD_INNER // SSD_GROUPS), SUBLN_EPS)
    ssd_out = y.reshape(b, s, SSD_INNER) @ w_branch_ssd

    g_attn, g_ssd = jnp.split(jax.nn.sigmoid(gate_logits + b_gate), N_BRANCH, axis=-1)
    mixed = (g_attn * attn_out + g_ssd * ssd_out) @ w_mix_out
    x = x + _rmsnorm(mixed, mix_post_g)

    hq = _rmsnorm(x, xa_pre_g)
    qx = (hq @ xa_w_q).reshape(b, s, XA_HEADS, XA_HEAD_DIM)
    kx, vx = jnp.split(_rmsnorm(mem, mem_norm_g) @ xa_w_kv, 2, axis=-1)
    m = mem.shape[1]
    kx = kx.reshape(b, m, XA_HEADS, XA_HEAD_DIM)
    vx = vx.reshape(b, m, XA_HEADS, XA_HEAD_DIM)
    sc = jnp.einsum('bqhd,bkhd->bhqk', qx, kx).astype(jnp.float32) * (XA_HEAD_DIM ** -0.5)
    p = jax.nn.softmax(sc, axis=-1).astype(vx.dtype)
    xo = jnp.einsum('bhqk,bkhd->bqhd', p, vx).reshape(b, s, D_MODEL) @ xa_w_o
    x = x + _rmsnorm(xo, xa_post_g)

    x = x + 0.5 * _rmsnorm(_swiglu(_rmsnorm(x, ffn2_pre_g), ffn2_w_gu, ffn2_w_down), ffn2_post_g)
    return x


def setup_inputs(seed: int = 0) -> dict:
    key = jax.random.key(seed)
    ks = iter(jax.random.split(key, 48))
    L = DEPTH

    def nrm(shape, scale):
        return scale * jax.random.normal(next(ks), shape, jnp.float32)

    def gain(n):
        return 1.0 + 0.02 * jax.random.normal(next(ks), (L, n), jnp.float32)

    inp = {}
    inp["x"] = nrm((BATCH, SEQ, D_MODEL), 1.0)
    inp["mem"] = nrm((BATCH, MEM_LEN, D_MODEL), 1.0)
    inp["ffn1_pre_g"] = gain(D_MODEL)
    inp["ffn1_post_g"] = gain(D_MODEL)
    inp["ffn1_w_gu"] = nrm((L, D_MODEL, 2 * D_FF), D_MODEL ** -0.5)
    inp["ffn1_w_down"] = nrm((L, D_FF, D_MODEL), D_FF ** -0.5)
    inp["mix_pre_g"] = gain(D_MODEL)
    inp["mix_post_g"] = gain(D_MODEL)
    inp["w_in"] = nrm((L, D_MODEL, IN_WIDTH), D_MODEL ** -0.5)
    inp["b_gate"] = nrm((L, N_BRANCH * D_MODEL), 0.02)
    inp["da_lambda_q1"] = nrm((L, DA_HEAD_DIM), 0.1)
    inp["da_lambda_k1"] = nrm((L, DA_HEAD_DIM), 0.1)
    inp["da_lambda_q2"] = nrm((L, DA_HEAD_DIM), 0.1)
    inp["da_lambda_k2"] = nrm((L, DA_HEAD_DIM), 0.1)
    inp["da_subln_g"] = gain(2 * DA_HEAD_DIM)
    inp["ssd_conv_w"] = nrm((L, SSD_CONV, SSD_CONV_DIM), SSD_CONV ** -0.5)
    inp["ssd_conv_b"] = nrm((L, SSD_CONV_DIM), 0.02)
    u = jax.random.uniform(next(ks), (L, SSD_HEADS), jnp.float32)
    dt0 = jnp.exp(u * (math.log(0.1) - math.log(0.001)) + math.log(0.001))
    inp["ssd_dt_bias"] = dt0 + jnp.log(-jnp.expm1(-dt0))
    inp["ssd_A_log"] = jnp.log(jax.random.uniform(next(ks), (L, SSD_HEADS), jnp.float32, 1.0, 16.0))
    inp["ssd_D"] = 1.0 + nrm((L, SSD_HEADS), 0.1)
    inp["ssd_norm_g"] = gain(SSD_INNER)
    inp["w_branch_attn"] = nrm((L, DA_V, D_MODEL), DA_V ** -0.5)
    inp["w_branch_ssd"] = nrm((L, SSD_INNER, D_MODEL), SSD_INNER ** -0.5)
    inp["w_mix_out"] = nrm((L, D_MODEL, D_MODEL), D_MODEL ** -0.5)
    inp["xa_pre_g"] = gain(D_MODEL)
    inp["xa_post_g"] = gain(D_MODEL)
    inp["mem_norm_g"] = gain(D_MODEL)
    inp["xa_w_q"] = nrm((L, D_MODEL, D_MODEL), D_MODEL ** -0.5)
    inp["xa_w_kv"] = nrm((L, D_MODEL, 2 * D_MODEL), D_MODEL ** -0.5)
    inp["xa_w_o"] = nrm((L, D_MODEL, D_MODEL), D_MODEL ** -0.5)
    inp["ffn2_pre_g"] = gain(D_MODEL)
    inp["ffn2_post_g"] = gain(D_MODEL)
    inp["ffn2_w_gu"] = nrm((L, D_MODEL, 2 * D_FF), D_MODEL ** -0.5)
    inp["ffn2_w_down"] = nrm((L, D_FF, D_MODEL), D_FF ** -0.5)
    return inp


def reference(x, mem, ffn1_pre_g, ffn1_post_g, ffn1_w_gu, ffn1_w_down,
              mix_pre_g, mix_post_g, w_in, b_gate,
              da_lambda_q1, da_lambda_k1, da_lambda_q2, da_lambda_k2, da_subln_g,
              ssd_conv_w, ssd_conv_b, ssd_dt_bias, ssd_A_log, ssd_D, ssd_norm_g,
              w_branch_attn, w_branch_ssd, w_mix_out,
              xa_pre_g, xa_post_g, mem_norm_g, xa_w_q, xa_w_kv, xa_w_o,
              ffn2_pre_g, ffn2_post_g, ffn2_w_gu, ffn2_w_down):
    for l in range(DEPTH):
        x = _layer(x, mem, l,
                   ffn1_pre_g[l], ffn1_post_g[l], ffn1_w_gu[l], ffn1_w_down[l],
                   mix_pre_g[l], mix_post_g[l], w_in[l], b_gate[l],
                   da_lambda_q1[l], da_lambda_k1[l], da_lambda_q2[l], da_lambda_k2[l], da_subln_g[l],
                   ssd_conv_w[l], ssd_conv_b[l], ssd_dt_bias[l], ssd_A_log[l], ssd_D[l], ssd_norm_g[l],
                   w_branch_attn[l], w_branch_ssd[l], w_mix_out[l],
                   xa_pre_g[l], xa_post_g[l], mem_norm_g[l], xa_w_q[l], xa_w_kv[l], xa_w_o[l],
                   ffn2_pre_g[l], ffn2_post_g[l], ffn2_w_gu[l], ffn2_w_down[l])
    return x
```

```cpp
#include <hip/hip_runtime.h>
#include <hip/hip_cooperative_groups.h>
#include <cstdio>
#include <cstdint>
namespace cg = cooperative_groups;
namespace pg8 {
#define PG8_LAS __attribute__((address_space(3)))
typedef unsigned short bf16_t;
typedef short bf16x8 __attribute__((ext_vector_type(8)));
typedef float f32x4 __attribute__((ext_vector_type(4)));
typedef unsigned u32x4 __attribute__((ext_vector_type(4)));
constexpr int BM = 256, BK = 64, HALF = 128, HTB = HALF * BK * 2  , STAGE_BYTES = 8 * HTB, NXCD = 8, WGM = 8;

__host__ __device__ __forceinline__ int lds_byte(int r, int c) { const int st = (r >> 4) * 2 + (c >> 5), rr = r & 15, cc = c & 31, ob = rr * 64 + cc * 2; return st * 1024 + (ob ^ (((ob >> 9) & 1) << 5)); }
__host__ __device__ __forceinline__ void stage_rc(int b, int& R, int& C) { const int st = b / 1024, sb = b % 1024, swz = sb ^ (((sb >> 9) & 1) << 5); R = (st >> 1) * 16 + swz / 64; C = (st & 1) * 32 + (swz % 64) / 2; }
__host__ __device__ __forceinline__ int perm32(int rho) { const int n = rho >> 4, i = rho & 15; return 8 * (i >> 2) + 4 * n + (i & 3); }

struct Unit { int pm, pn; };
struct Gemm { const bf16_t* A; const bf16_t* Bt; int M, N, K; };

struct StaticOrder {
    int nM, nN, nwg, G, c;
    __host__ __device__ void init(int M, int N, int G_, int c_) { nM = M / BM; nN = N / BM; nwg = nM * nN; G = G_; c = c_; }
    __host__ __device__ __forceinline__ bool next(int i, Unit& u) const {
        const long L = (long)i * G + c; if (L >= nwg) return false;
        int wgid = (int)L; { const int q = nwg / NXCD, r = nwg % NXCD, xcd = wgid % NXCD, off = wgid / NXCD; wgid = (xcd < r ? xcd * (q + 1) : r * (q + 1) + (xcd - r) * q) + off; }
        const int nig = WGM * nN, gid = wgid / nig, fm = gid * WGM, gsz = (nM - fm) < WGM ? (nM - fm) : WGM;
        u.pm = fm + ((wgid % nig) % gsz); u.pn = (wgid % nig) / gsz; return true;
    }
    __device__ __forceinline__ void a_ready(const Unit&) const {}
    __device__ __forceinline__ void done(const Unit&) const {}
};

__device__ __forceinline__ unsigned cvt_pk_bf16(float lo, float hi) { unsigned r; asm volatile("v_cvt_pk_bf16_f32 %0, %1, %2" : "=v"(r) : "v"(lo), "v"(hi)); return r; }
typedef float f32x2 __attribute__((ext_vector_type(2)));
typedef unsigned u32x2 __attribute__((ext_vector_type(2)));
__device__ __forceinline__ float fsigmoid(float x) { return __builtin_amdgcn_rcpf(1.0f + __builtin_amdgcn_exp2f(-1.4426950408889634f * x)); }
__device__ __forceinline__ float fsilu(float x) { return x * fsigmoid(x); }
__device__ __forceinline__ float bf_lo(unsigned w) { return __uint_as_float(w << 16); }
__device__ __forceinline__ float bf_hi(unsigned w) { return __uint_as_float(w & 0xffff0000u); }
__device__ __forceinline__ u32x4 pack8(f32x4 v0, f32x4 v1) { u32x4 w; w.x = cvt_pk_bf16(v0[0], v0[1]); w.y = cvt_pk_bf16(v0[2], v0[3]); w.z = cvt_pk_bf16(v1[0], v1[1]); w.w = cvt_pk_bf16(v1[2], v1[3]); return w; }

template <int ACT  > struct EpiB {
    static constexpr bool PERM = true, AFTER_DRAIN = false;
    bf16_t* O; int ldc; const float* bias; int split_cols; size_t split_stride;
    __device__ __forceinline__ void operator()(const f32x4 (&acc)[2][2][4][2], const Unit& u, int wr, int wc, int fr, int fq) const {
        const int row0 = u.pm * BM + wr * 64 + fr; int colt = u.pn * BM; bf16_t* base = O;
        if (split_cols) { const int t = colt / split_cols; base += (size_t)t * split_stride; colt -= t * split_cols; }
        const int col0 = colt + wc * 32 + 8 * fq, bcol0 = u.pn * BM + wc * 32 + 8 * fq;
        f32x4 bv[2][2];
#pragma unroll
        for (int bj = 0; bj < 2; ++bj)
#pragma unroll
            for (int n = 0; n < 2; ++n) bv[bj][n] = bias ? *(const f32x4*)(bias + bcol0 + bj * HALF + 4 * n) : (f32x4){0.f, 0.f, 0.f, 0.f};
#pragma unroll
        for (int ai = 0; ai < 2; ++ai)
#pragma unroll
            for (int m = 0; m < 4; ++m) { bf16_t* rowp = base + (size_t)(row0 + ai * HALF + m * 16) * ldc + col0;
#pragma unroll
                for (int bj = 0; bj < 2; ++bj) { f32x4 v0 = acc[ai][bj][m][0] + bv[bj][0], v1 = acc[ai][bj][m][1] + bv[bj][1];
                    if (ACT == 2) {
#pragma unroll
                        for (int j = 0; j < 4; ++j) { v0[j] = fsigmoid(v0[j]); v1[j] = fsigmoid(v1[j]); } }
                    *(u32x4*)(rowp + bj * HALF) = pack8(v0, v1); } }
    }
};
struct EpiSwiglu {
    static constexpr bool PERM = true, AFTER_DRAIN = false;
    bf16_t* O; int ldc;
    __device__ __forceinline__ void operator()(const f32x4 (&acc)[2][2][4][2], const Unit& u, int wr, int wc, int fr, int fq) const {
        const int row0 = u.pm * BM + wr * 64 + fr; const int col0 = u.pn * HALF + wc * 32 + 8 * fq;
#pragma unroll
        for (int ai = 0; ai < 2; ++ai)
#pragma unroll
            for (int m = 0; m < 4; ++m) { bf16_t* rowp = O + (size_t)(row0 + ai * HALF + m * 16) * ldc + col0;
                f32x4 h0, h1;
#pragma unroll
                for (int j = 0; j < 4; ++j) { h0[j] = fsilu(acc[ai][0][m][0][j]) * acc[ai][1][m][0][j]; h1[j] = fsilu(acc[ai][0][m][1][j]) * acc[ai][1][m][1][j]; }
                *(u32x4*)rowp = pack8(h0, h1); }
    }
};
struct EpiF32 {
    static constexpr bool PERM = false, AFTER_DRAIN = false;
    float* O; int ldc;
    __device__ __forceinline__ void operator()(const f32x4 (&acc)[2][2][4][2], const Unit& u, int wr, int wc, int fr, int fq) const {
        const int row0 = u.pm * BM + wr * 64 + fr; const int col0 = u.pn * BM + wc * 32 + 4 * fq;
#pragma unroll
        for (int ai = 0; ai < 2; ++ai)
#pragma unroll
            for (int m = 0; m < 4; ++m) { float* rowp = O + (size_t)(row0 + ai * HALF + m * 16) * ldc + col0;
#pragma unroll
                for (int bj = 0; bj < 2; ++bj)
#pragma unroll
                    for (int n = 0; n < 2; ++n) *(f32x4*)(rowp + bj * HALF + n * 16) = acc[ai][bj][m][n]; }
    }
};
struct EpiInB {
    static constexpr bool PERM = true, AFTER_DRAIN = false;
    bf16_t* Z; bf16_t* XS; bf16_t* BC; float* dtT; const float* dt_bias; int Mrows;
    __device__ __forceinline__ void operator()(const f32x4 (&acc)[2][2][4][2], const Unit& u, int wr, int wc, int fr, int fq) const {
        const int row0 = u.pm * BM + wr * 64 + fr;
        if (u.pn < 20) {
            bf16_t* base; int ldc, colt;
            if (u.pn < 8) { base = Z; ldc = 2048; colt = u.pn * BM; } else if (u.pn < 16) { base = XS; ldc = 2048; colt = (u.pn - 8) * BM; } else { base = BC; ldc = 1024; colt = (u.pn - 16) * BM; }
            const int col0 = colt + wc * 32 + 8 * fq;
#pragma unroll
            for (int ai = 0; ai < 2; ++ai)
#pragma unroll
                for (int m = 0; m < 4; ++m) { bf16_t* rowp = base + (size_t)(row0 + ai * HALF + m * 16) * ldc + col0;
#pragma unroll
                    for (int bj = 0; bj < 2; ++bj) *(u32x4*)(rowp + bj * HALF) = pack8(acc[ai][bj][m][0], acc[ai][bj][m][1]); }
        } else if (wc == 0) {
#pragma unroll
            for (int ai = 0; ai < 2; ++ai)
#pragma unroll
                for (int m = 0; m < 4; ++m) { const int row = row0 + ai * HALF + m * 16;
#pragma unroll
                    for (int n = 0; n < 2; ++n)
#pragma unroll
                        for (int j = 0; j < 4; ++j) { const int c = 8 * fq + 4 * n + j; const float x = acc[ai][0][m][n][j] + dt_bias[c];
                            dtT[(size_t)c * Mrows + row] = x > 20.f ? x : log1pf(__expf(x)); } }
        }
    }
};
template <bool ADD> struct EpiBranch {
    static constexpr bool PERM = true, AFTER_DRAIN = false;
    const bf16_t* G; const bf16_t* Tm; bf16_t* D; const float* gbias;
    __device__ __forceinline__ void operator()(const f32x4 (&acc)[2][2][4][2], const Unit& u, int wr, int wc, int fr, int fq) const {
        const int row0 = u.pm * BM + wr * 64 + fr; const int col0 = u.pn * BM + wc * 32 + 8 * fq;
        float gb[2][8];
#pragma unroll
        for (int bj = 0; bj < 2; ++bj)
#pragma unroll
            for (int j = 0; j < 8; ++j) gb[bj][j] = gbias[col0 + bj * HALF + j];
#pragma unroll
        for (int ai = 0; ai < 2; ++ai) {
            u32x4 gv[4][2], tv[4][2];
#pragma unroll
            for (int m = 0; m < 4; ++m)
#pragma unroll
                for (int bj = 0; bj < 2; ++bj) { const size_t off = (size_t)(row0 + ai * HALF + m * 16) * 1024 + col0 + bj * HALF;
                    gv[m][bj] = *(const u32x4*)(G + off); tv[m][bj] = ADD ? *(const u32x4*)(Tm + off) : (u32x4){0u, 0u, 0u, 0u}; }
#pragma unroll
            for (int m = 0; m < 4; ++m)
#pragma unroll
                for (int bj = 0; bj < 2; ++bj) { const size_t off = (size_t)(row0 + ai * HALF + m * 16) * 1024 + col0 + bj * HALF;
                    const u32x4 g4 = gv[m][bj], t4 = tv[m][bj];
                    f32x4 v0 = acc[ai][bj][m][0], v1 = acc[ai][bj][m][1];
                    v0[0] = fsigmoid(bf_lo(g4.x) + gb[bj][0]) * v0[0] + bf_lo(t4.x); v0[1] = fsigmoid(bf_hi(g4.x) + gb[bj][1]) * v0[1] + bf_hi(t4.x);
                    v0[2] = fsigmoid(bf_lo(g4.y) + gb[bj][2]) * v0[2] + bf_lo(t4.y); v0[3] = fsigmoid(bf_hi(g4.y) + gb[bj][3]) * v0[3] + bf_hi(t4.y);
                    v1[0] = fsigmoid(bf_lo(g4.z) + gb[bj][4]) * v1[0] + bf_lo(t4.z); v1[1] = fsigmoid(bf_hi(g4.z) + gb[bj][5]) * v1[1] + bf_hi(t4.z);
                    v1[2] = fsigmoid(bf_lo(g4.w) + gb[bj][6]) * v1[2] + bf_lo(t4.w); v1[3] = fsigmoid(bf_hi(g4.w) + gb[bj][7]) * v1[3] + bf_hi(t4.w);
                    *(u32x4*)(D + off) = pack8(v0, v1); }
        }
    }
};
template <class Epi, class Sched, bool ALIGN_EPI = false, bool SP2 = false>
__device__ __forceinline__ void gemm_phase(PG8_LAS unsigned char* lds, const Gemm g, const Sched& S, const Epi& E) {
    const int tid = threadIdx.x, wid = __builtin_amdgcn_readfirstlane(tid >> 6), lane = tid & 63, wr = wid >> 2, wc = wid & 3, fr = lane & 15, fq = lane >> 4;
    const int K = g.K, nt = K / BK;
    unsigned voffA[2], voffB[2];
#pragma unroll
    for (int i = 0; i < 2; ++i) { int R, C; stage_rc(tid * 16 + i * 8192, R, C); const int Rb = Epi::PERM ? ((R & ~31) + perm32(R & 31)) : R;
        voffA[i] = (unsigned)(R * K + C) * 2u; voffB[i] = (unsigned)(Rb * K + C) * 2u; }
    const size_t kstep = (size_t)(BK * 2);
    const size_t hstep = (size_t)HALF * K * 2;
    const size_t tstep = 2 * hstep;
    const unsigned ldsw = (unsigned)wid * 1024u;
    const int aoff = lds_byte(wr * 64 + fr, fq * 8), boff = lds_byte(wc * 32 + fr, fq * 8);
#define PG8_SA(b, h) (((b) * 2 + (h)) * HTB)
#define PG8_SB(b, h) ((4 + (b) * 2 + (h)) * HTB)
#define PG8_STAGE(bufoff, gbase, voff) do { _Pragma("unroll") for (int _i = 0; _i < 2; ++_i) \
        __builtin_amdgcn_global_load_lds((const unsigned*)((const char*)(gbase) + (voff)[_i]), (PG8_LAS unsigned*)(lds + (bufoff) + ldsw + _i * 8192), 16, 0, 0); } while (0)
#define PG8_LDA(dst, b, h) do { _Pragma("unroll") for (int m = 0; m < 4; ++m) _Pragma("unroll") for (int k = 0; k < 2; ++k) dst[m][k] = *(const PG8_LAS bf16x8*)(lds + PG8_SA(b, h) + aoff + m * 2048 + k * 1024); } while (0)
#define PG8_LDB(dst, b, h) do { _Pragma("unroll") for (int n = 0; n < 2; ++n) _Pragma("unroll") for (int k = 0; k < 2; ++k) dst[n][k] = *(const PG8_LAS bf16x8*)(lds + PG8_SB(b, h) + boff + n * 2048 + k * 1024); } while (0)
#define PG8_MMA(ai, bj, At, Bt) do { __builtin_amdgcn_s_setprio(1); _Pragma("unroll") for (int m = 0; m < 4; ++m) _Pragma("unroll") for (int n = 0; n < 2; ++n) _Pragma("unroll") for (int k = 0; k < 2; ++k) \
        acc[ai][bj][m][n] = __builtin_amdgcn_mfma_f32_16x16x32_bf16(Bt[n][k], At[m][k], acc[ai][bj][m][n], 0, 0, 0); __builtin_amdgcn_s_setprio(0); } while (0)
#define PG8_WAIT_V(n) asm volatile("s_waitcnt vmcnt(" #n ")" ::: "memory")
#define PG8_WAIT_L(n) asm volatile("s_waitcnt lgkmcnt(" #n ")" ::: "memory")
#define PG8_BAR __builtin_amdgcn_s_barrier()
#define PG8_SCHED __builtin_amdgcn_sched_barrier(0)
    Unit cur, nxt; int ui = 0;
    if (!S.next(0, cur)) return;
    f32x4 acc[2][2][4][2];
#pragma unroll
    for (int a = 0; a < 2; ++a)
#pragma unroll
        for (int b = 0; b < 2; ++b)
#pragma unroll
            for (int m = 0; m < 4; ++m)
#pragma unroll
                for (int n = 0; n < 2; ++n) acc[a][b][m][n] = (f32x4){0.f, 0.f, 0.f, 0.f};
    bf16x8 At[4][2], B0[2][2], B1[2][2];
    const char* cA = (const char*)g.A + (size_t)cur.pm * tstep; const char* cB = (const char*)g.Bt + (size_t)cur.pn * tstep;
    S.a_ready(cur);
    if constexpr (SP2) {
        PG8_STAGE(PG8_SB(0, 0), cB, voffB); PG8_STAGE(PG8_SB(0, 1), cB + hstep, voffB); PG8_STAGE(PG8_SA(0, 0), cA, voffA); PG8_STAGE(PG8_SA(0, 1), cA + hstep, voffA);
        if (wr == 1) PG8_BAR;
        PG8_WAIT_V(2); PG8_BAR;
        PG8_STAGE(PG8_SB(1, 0), cB + kstep, voffB); PG8_STAGE(PG8_SA(1, 0), cA + kstep, voffA); PG8_STAGE(PG8_SB(1, 1), cB + hstep + kstep, voffB);
        PG8_WAIT_V(6); PG8_BAR;
    } else {
        PG8_STAGE(PG8_SB(0, 0), cB, voffB); PG8_STAGE(PG8_SA(0, 0), cA, voffA); PG8_STAGE(PG8_SB(0, 1), cB + hstep, voffB); PG8_STAGE(PG8_SA(0, 1), cA + hstep, voffA);
        if (wr == 1) PG8_BAR;
        PG8_WAIT_V(4); PG8_BAR;
        PG8_STAGE(PG8_SB(1, 0), cB + kstep, voffB); PG8_STAGE(PG8_SA(1, 0), cA + kstep, voffA); PG8_STAGE(PG8_SB(1, 1), cB + hstep + kstep, voffB);
        PG8_WAIT_V(6); PG8_BAR;
    }
    for (;;) {
        const bool has_next = S.next(ui + 1, nxt);
        const char* nA = has_next ? (const char*)g.A + (size_t)nxt.pm * tstep : cA; const char* nB = has_next ? (const char*)g.Bt + (size_t)nxt.pn * tstep : cB;
        for (int t = 0; t < nt; t += 2) {
            const bool last = (t == nt - 2);
            const char* a1 = cA + (size_t)(t + 1) * kstep;
            const char* a2 = last ? nA : cA + (size_t)(t + 2) * kstep; const char* b2 = last ? nB : cB + (size_t)(t + 2) * kstep;
            const char* a3 = a2 + kstep; const char* b3 = b2 + kstep;
            if (last && has_next) S.a_ready(nxt);
            if constexpr (SP2) {
            PG8_LDB(B0, 0, 0); PG8_LDB(B1, 0, 1); PG8_SCHED; PG8_LDA(At, 0, 0); PG8_STAGE(PG8_SA(1, 1), a1 + hstep, voffA);
            PG8_WAIT_V(8); PG8_WAIT_L(0); PG8_BAR; PG8_MMA(0, 0, At, B0); PG8_MMA(0, 1, At, B1); PG8_BAR; PG8_SCHED;
            PG8_LDA(At, 0, 1); PG8_STAGE(PG8_SB(0, 0), b2, voffB); PG8_STAGE(PG8_SB(0, 1), b2 + hstep, voffB); PG8_STAGE(PG8_SA(0, 0), a2, voffA);
            PG8_WAIT_V(8); PG8_WAIT_L(0); PG8_BAR; PG8_MMA(1, 0, At, B0); PG8_MMA(1, 1, At, B1); PG8_BAR; PG8_SCHED;
            PG8_LDB(B0, 1, 0); PG8_LDB(B1, 1, 1); PG8_SCHED; PG8_LDA(At, 1, 0); PG8_STAGE(PG8_SA(0, 1), a2 + hstep, voffA);
            PG8_WAIT_V(8); PG8_WAIT_L(0); PG8_BAR; PG8_MMA(0, 0, At, B0); PG8_MMA(0, 1, At, B1); PG8_BAR; PG8_SCHED;
            PG8_LDA(At, 1, 1); PG8_STAGE(PG8_SB(1, 0), b3, voffB); PG8_STAGE(PG8_SB(1, 1), b3 + hstep, voffB); PG8_STAGE(PG8_SA(1, 0), a3, voffA);
            PG8_WAIT_V(8); PG8_WAIT_L(0); PG8_BAR; PG8_MMA(1, 0, At, B0); PG8_MMA(1, 1, At, B1); PG8_BAR; PG8_SCHED;
            } else {
            PG8_LDB(B0, 0, 0); PG8_SCHED; PG8_LDA(At, 0, 0); PG8_STAGE(PG8_SA(1, 1), a1 + hstep, voffA);
            PG8_WAIT_L(8); PG8_BAR; PG8_WAIT_L(0); PG8_MMA(0, 0, At, B0); PG8_BAR; PG8_SCHED;
            PG8_LDB(B1, 0, 1); PG8_STAGE(PG8_SB(0, 0), b2, voffB);
            PG8_BAR; PG8_WAIT_L(0); PG8_MMA(0, 1, At, B1); PG8_BAR;
            PG8_LDA(At, 0, 1); PG8_STAGE(PG8_SA(0, 0), a2, voffA);
            PG8_BAR; PG8_WAIT_L(0); PG8_MMA(1, 0, At, B0); PG8_BAR; PG8_SCHED;
            PG8_STAGE(PG8_SB(0, 1), b2 + hstep, voffB);
            PG8_WAIT_V(6); PG8_BAR; PG8_MMA(1, 1, At, B1); PG8_BAR;
            PG8_LDB(B0, 1, 0); PG8_SCHED; PG8_LDA(At, 1, 0); PG8_STAGE(PG8_SA(0, 1), a2 + hstep, voffA);
            PG8_WAIT_L(8); PG8_BAR; PG8_WAIT_L(0); PG8_MMA(0, 0, At, B0); PG8_BAR; PG8_SCHED;
            PG8_LDB(B1, 1, 1); PG8_STAGE(PG8_SB(1, 0), b3, voffB);
            PG8_BAR; PG8_WAIT_L(0); PG8_MMA(0, 1, At, B1); PG8_BAR;
            PG8_LDA(At, 1, 1); PG8_STAGE(PG8_SA(1, 0), a3, voffA);
            PG8_BAR; PG8_WAIT_L(0); PG8_MMA(1, 0, At, B0); PG8_BAR; PG8_SCHED;
            PG8_STAGE(PG8_SB(1, 1), b3 + hstep, voffB);
            PG8_WAIT_V(6); PG8_BAR; PG8_MMA(1, 1, At, B1); PG8_BAR;
            }
        }
        if constexpr (ALIGN_EPI) { if (wr == 0) PG8_BAR; }
        if constexpr (!Epi::AFTER_DRAIN) { E(acc, cur, wr, wc, fr, fq); S.done(cur); }
        if (!has_next) break;
#pragma unroll
        for (int a = 0; a < 2; ++a)
#pragma unroll
            for (int b = 0; b < 2; ++b)
#pragma unroll
                for (int m = 0; m < 4; ++m)
#pragma unroll
                    for (int n = 0; n < 2; ++n) acc[a][b][m][n] = (f32x4){0.f, 0.f, 0.f, 0.f};
        cur = nxt; cA = nA; cB = nB; ++ui;
        if constexpr (ALIGN_EPI) { if (wr == 1) PG8_BAR; }
    }
    PG8_WAIT_V(0);
    if constexpr (!ALIGN_EPI) { if (wr == 0) PG8_BAR; }
    PG8_BAR;
    if constexpr (Epi::AFTER_DRAIN) { E.fused(acc, cur, wr, wc, fr, fq, lds, wid, lane); S.done(cur); }
#undef PG8_SA
#undef PG8_SB
#undef PG8_STAGE
#undef PG8_LDA
#undef PG8_LDB
#undef PG8_MMA
#undef PG8_WAIT_V
#undef PG8_WAIT_L
#undef PG8_BAR
#undef PG8_SCHED
}
}
#define LAS __attribute__((address_space(3)))
typedef unsigned short bf16_t;
typedef short bf16x8 __attribute__((ext_vector_type(8)));
typedef short s16x4 __attribute__((ext_vector_type(4)));
typedef float f32x4 __attribute__((ext_vector_type(4)));
typedef float f32x16 __attribute__((ext_vector_type(16)));
typedef unsigned u32x4 __attribute__((ext_vector_type(4)));
typedef unsigned u32x2 __attribute__((ext_vector_type(2)));

constexpr int T_ = 16384, SEQ_ = 4096, NB_ = 4, DM_ = 1024, DFF_ = 2816, MEMT_ = 1024;
constexpr int NWAVES = 8, NTHREADS = 512;
constexpr int LDS_BYTES = 155648;
constexpr size_t MiB = 1u << 20;
constexpr size_t WS_KX = 1 * MiB, WS_VXT = 3 * MiB, WS_DTT = 5 * MiB, WS_WIN = 7 * MiB, WS_ABUF = 24 * MiB, WS_Q = 56 * MiB, WS_K = 88 * MiB, WS_VT = 120 * MiB;
constexpr size_t WS_Z = 88 * MiB, WS_XS = 152 * MiB, WS_BC = 216 * MiB;
constexpr size_t WS_HBUF = 56 * MiB, WS_YBUF_A = 152 * MiB, WS_YBUF_B = 88 * MiB;
constexpr size_t WS_WGU = 216 * MiB, WS_WD = 227 * MiB, WS_WKV = 233 * MiB, WS_MEMN = 237 * MiB;
constexpr size_t WS_WG = 7 * MiB, WS_WBA = 11 * MiB, WS_WBS = 13 * MiB, WS_WMO = 17 * MiB, WS_WQ = 19 * MiB, WS_WO = 21 * MiB;
constexpr size_t WS_GA = 152 * MiB, WS_GS = 184 * MiB, WS_TMP = 216 * MiB, WS_QX = 56 * MiB, WS_XO = 152 * MiB;
constexpr size_t WS_NEED = 248 * MiB;

__device__ __forceinline__ float wave_sum(float v) {
#pragma unroll
    for (int o = 1; o < 64; o <<= 1) v += __shfl_xor(v, o);
    return v;
}
typedef float f32x2_t __attribute__((ext_vector_type(2))); typedef __bf16 bf16x2_t __attribute__((ext_vector_type(2)));
__device__ __forceinline__ unsigned pk2(float lo, float hi) { f32x2_t v = {lo, hi}; bf16x2_t b = __builtin_convertvector(v, bf16x2_t); return __builtin_bit_cast(unsigned, b); }
__device__ __forceinline__ unsigned short bf1(float x) { return (unsigned short)(pk2(x, 0.f) & 0xffffu); }
__device__ __forceinline__ float bflo(unsigned w) { return __uint_as_float(w << 16); }
__device__ __forceinline__ float bfhi(unsigned w) { return __uint_as_float(w & 0xffff0000u); }
__device__ __forceinline__ float bf2f(unsigned short h) { return __uint_as_float(((unsigned)h) << 16); }
__device__ __forceinline__ float fsigm(float x) { return __builtin_amdgcn_rcpf(1.0f + __builtin_amdgcn_exp2f(-1.4426950408889634f * x)); }
__device__ __forceinline__ int crow(int r, int hi) { return (r & 3) + 8 * (r >> 2) + 4 * hi; }
#define MFMA32(a, b, c) __builtin_amdgcn_mfma_f32_32x32x16_bf16((a), (b), (c), 0, 0, 0)

__device__ __forceinline__ void tr_job(const float* W, int K, int N, int ncol0, int ncols, bf16_t* WT, int mode, LAS float* scr, int gw, int NGW, int lane, int& itbase) {
    const int nblk = ncols / 32, nitems = (K / 64) * nblk;
    int first = (gw - (itbase % NGW) + NGW) % NGW;
    for (int it = first; it < nitems; it += NGW) {
        const int kb = it / nblk, nb = it % nblk, k0 = 64 * kb, n0 = ncol0 + 32 * nb;
        int drow0;
        if (mode == 0) drow0 = n0 - ncol0;
        else { const int c = n0 < DFF_ ? n0 : n0 - DFF_; drow0 = 256 * (c / 128) + (c % 128) + (n0 < DFF_ ? 0 : 128); }
#pragma unroll
        for (int i = 0; i < 8; ++i) { const int kk = 8 * i + (lane >> 3), n4 = 4 * (lane & 7); const f32x4 v = __builtin_nontemporal_load((const f32x4*)(W + (size_t)(k0 + kk) * N + n0 + n4));
            scr[kk * 33 + n4] = v.x; scr[kk * 33 + n4 + 1] = v.y; scr[kk * 33 + n4 + 2] = v.z; scr[kk * 33 + n4 + 3] = v.w; }
        asm volatile("s_waitcnt lgkmcnt(0)" ::: "memory");
        const int c = lane & 7;
#pragma unroll
        for (int j = 0; j < 4; ++j) { const int n = (lane >> 3) + 8 * j; const LAS float* s = scr + (8 * c) * 33 + n;
            u32x4 o; o.x = pk2(s[0 * 33], s[1 * 33]); o.y = pk2(s[2 * 33], s[3 * 33]); o.z = pk2(s[4 * 33], s[5 * 33]); o.w = pk2(s[6 * 33], s[7 * 33]);
            *(u32x4*)(WT + (size_t)(drow0 + n) * K + k0 + 8 * c) = o; }
        asm volatile("s_waitcnt lgkmcnt(0)" ::: "memory");
    }
    itbase += nitems;
}

template <bool BF> __device__ __forceinline__ void load_row(f32x4 (&r)[4], const void* base, size_t m, int lane) {
    if (BF) { const u32x2* p = (const u32x2*)((const bf16_t*)base + m * DM_) + lane;
#pragma unroll
        for (int j = 0; j < 4; ++j) { const u32x2 w = p[64 * j]; r[j] = (f32x4){bflo(w.x), bfhi(w.x), bflo(w.y), bfhi(w.y)}; } }
    else { const f32x4* p = (const f32x4*)((const float*)base + m * DM_) + lane;
#pragma unroll
        for (int j = 0; j < 4; ++j) r[j] = p[64 * j]; }
}
__device__ __forceinline__ void add_normed(f32x4 (&r)[4], const bf16_t* y, size_t m, const float* gpost, float coef, int lane) {
    const u32x2* yr = (const u32x2*)(y + m * DM_) + lane; f32x4 v[4]; float s = 0.f;
#pragma unroll
    for (int j = 0; j < 4; ++j) { const u32x2 w = yr[64 * j]; v[j] = (f32x4){bflo(w.x), bfhi(w.x), bflo(w.y), bfhi(w.y)}; s += (v[j].x * v[j].x + v[j].y * v[j].y) + (v[j].z * v[j].z + v[j].w * v[j].w); }
    const float rs = coef * __builtin_amdgcn_rsqf(wave_sum(s) * (1.f / DM_) + 1e-6f);
#pragma unroll
    for (int j = 0; j < 4; ++j) { const f32x4 g = ((const f32x4*)gpost)[lane + 64 * j]; r[j] = r[j] + v[j] * g * rs; }
}
template <bool RIN_BF, bool ROUT_BF>
__device__ __forceinline__ void rowwise(const bf16_t* y, const void* rin, const float* gpost, float coef, void* rout, const float* gpre, bf16_t* aout, int rows, int gw, int NGW, int lane) {
    const int per = (rows + NGW - 1) / NGW;
    for (int m = gw * per; m < gw * per + per && m < rows; ++m) {
        f32x4 r[4];
        load_row<RIN_BF>(r, rin, (size_t)m, lane);
        if (y) add_normed(r, y, (size_t)m, gpost, coef, lane);
        if (rout) {
            if (ROUT_BF) { u32x2* o = (u32x2*)((bf16_t*)rout + (size_t)m * DM_) + lane;
#pragma unroll
                for (int j = 0; j < 4; ++j) { u32x2 w; w.x = pk2(r[j].x, r[j].y); w.y = pk2(r[j].z, r[j].w); o[64 * j] = w; } }
            else { f32x4* o = (f32x4*)((float*)rout + (size_t)m * DM_) + lane;
#pragma unroll
                for (int j = 0; j < 4; ++j) o[64 * j] = r[j]; }
        }
        if (aout) {
            float s = 0.f;
#pragma unroll
            for (int j = 0; j < 4; ++j) s += (r[j].x * r[j].x + r[j].y * r[j].y) + (r[j].z * r[j].z + r[j].w * r[j].w);
            const float rs = __builtin_amdgcn_rsqf(wave_sum(s) * (1.f / DM_) + 1e-6f);
            u32x2* o = (u32x2*)(aout + (size_t)m * DM_) + lane;
#pragma unroll
            for (int j = 0; j < 4; ++j) { const f32x4 g = ((const f32x4*)gpre)[lane + 64 * j]; const f32x4 v = r[j] * g * rs; u32x2 w; w.x = pk2(v.x, v.y); w.y = pk2(v.z, v.w); o[64 * j] = w; }
        }
    }
}
__device__ __forceinline__ void groupnorm_rows(bf16_t* yb, const float* g, int rows, int gw, int NGW, int lane) {
    const int per = (rows + NGW - 1) / NGW;
    for (int m = gw * per; m < gw * per + per && m < rows; ++m) {
        u32x4 w[4];
#pragma unroll
        for (int j = 0; j < 4; ++j) w[j] = *((const u32x4*)(yb + (size_t)m * 2048 + j * 512) + lane);
#pragma unroll
        for (int j = 0; j < 4; ++j) {
            float v[8] = {bflo(w[j].x), bfhi(w[j].x), bflo(w[j].y), bfhi(w[j].y), bflo(w[j].z), bfhi(w[j].z), bflo(w[j].w), bfhi(w[j].w)};
            float s = 0.f;
#pragma unroll
            for (int k = 0; k < 8; ++k) s += v[k] * v[k];
            const float rs = __builtin_amdgcn_rsqf(wave_sum(s) * (1.f / 512.f) + 1e-5f);
            const f32x4 g0 = *(const f32x4*)(g + j * 512 + lane * 8), g1 = *(const f32x4*)(g + j * 512 + lane * 8 + 4);
            u32x4 o; o.x = pk2(v[0] * rs * g0.x, v[1] * rs * g0.y); o.y = pk2(v[2] * rs * g0.z, v[3] * rs * g0.w); o.z = pk2(v[4] * rs * g1.x, v[5] * rs * g1.y); o.w = pk2(v[6] * rs * g1.z, v[7] * rs * g1.w);
            w[j] = o;
        }
#pragma unroll
        for (int j = 0; j < 4; ++j) *((u32x4*)(yb + (size_t)m * 2048 + j * 512) + lane) = w[j];
    }
}

template <int DQK, bool CAUSAL, bool PREFETCH>
__device__ __forceinline__ void flash_pass(f32x16 (&o)[4], const bf16_t* Qrow, const bf16_t* Kbase, int kpitch, const bf16_t* VTbase, int vpitch, int NT, int qpos0, float cscale, LAS unsigned char* lds, int wid, int lane) {
    constexpr int KP = DQK + 8, ND = DQK / 16, KL = DQK / 64, KC = DQK / 8;
    const int tid = threadIdx.x, r32 = lane & 31, hi = lane >> 5;
    constexpr int KSB = 64 * KP * 2, BUFB = KSB + 18432;
    LAS bf16_t* Ks = (LAS bf16_t*)lds; LAS bf16_t* Vs = (LAS bf16_t*)(lds + KSB); volatile LAS float* wsf = (volatile LAS float*)(lds + 2 * BUFB) + wid * 64;
    constexpr bool QREG = (DQK <= 64);
    bf16x8 qf[QREG ? ND : 1];
    if (QREG) {
#pragma unroll
        for (int d0 = 0; d0 < ND; ++d0) qf[d0] = *(const bf16x8*)(Qrow + d0 * 16 + hi * 8);
    }
#pragma unroll
    for (int eb = 0; eb < 4; ++eb)
#pragma unroll
        for (int r = 0; r < 16; ++r) o[eb][r] = 0.f;
    float mrun = -1e30f, lrun = 0.f;
    u32x4 kst[KL], vst[2];
#pragma unroll
    for (int i = 0; i < KL; ++i) { const int ci = tid + NTHREADS * i, row = ci / KC, cc = ci % KC; kst[i] = *(const u32x4*)(Kbase + (size_t)row * kpitch + cc * 8); }
#pragma unroll
    for (int i = 0; i < 2; ++i) { const int ci = tid + NTHREADS * i, e = ci >> 3, cc = ci & 7; vst[i] = *(const u32x4*)(VTbase + (size_t)e * vpitch + cc * 8); }
#pragma unroll
    for (int i = 0; i < KL; ++i) { const int ci = tid + NTHREADS * i, row = ci / KC, cc = ci % KC; *(LAS u32x4*)(Ks + row * KP + cc * 8) = kst[i]; }
#pragma unroll
    for (int i = 0; i < 2; ++i) { const int ci = tid + NTHREADS * i, e = ci >> 3, cc = ci & 7; { LAS bf16_t* vd = Vs + e * 72 + (cc >> 1) * 16 + (cc & 1) * 4; *(LAS u32x2*)vd = (u32x2){vst[i].x, vst[i].y}; *(LAS u32x2*)(vd + 8) = (u32x2){vst[i].z, vst[i].w}; } }
    __syncthreads();
    for (int t = 0; t < NT; ++t) {
        Ks = (LAS bf16_t*)(lds + (t & 1) * BUFB); Vs = (LAS bf16_t*)(lds + (t & 1) * BUFB + KSB);
        if (PREFETCH && t + 1 < NT) {
#pragma unroll
            for (int i = 0; i < KL; ++i) { const int ci = tid + NTHREADS * i, row = ci / KC, cc = ci % KC; kst[i] = *(const u32x4*)(Kbase + (size_t)(64 * (t + 1) + row) * kpitch + cc * 8); }
#pragma unroll
            for (int i = 0; i < 2; ++i) { const int ci = tid + NTHREADS * i, e = ci >> 3, cc = ci & 7; vst[i] = *(const u32x4*)(VTbase + (size_t)e * vpitch + 64 * (t + 1) + cc * 8); }
        }
        const bool active = !CAUSAL || (64 * t <= qpos0 + 31);
        if (active) {
            f32x16 p0, p1;
#pragma unroll
            for (int r = 0; r < 16; ++r) { p0[r] = 0.f; p1[r] = 0.f; }
            if (QREG) {
#pragma unroll
                for (int d0 = 0; d0 < ND; ++d0) {
                    const bf16x8 k0 = *(const LAS bf16x8*)(Ks + r32 * KP + d0 * 16 + hi * 8);
                    const bf16x8 k1 = *(const LAS bf16x8*)(Ks + (32 + r32) * KP + d0 * 16 + hi * 8);
                    p0 = MFMA32(k0, qf[d0], p0); p1 = MFMA32(k1, qf[d0], p1);
                }
            } else {
#pragma unroll 1
                for (int dc = 0; dc < ND; dc += 8) {
                    bf16x8 q4[8];
#pragma unroll
                    for (int i = 0; i < 8; ++i) q4[i] = *(const bf16x8*)(Qrow + (dc + i) * 16 + hi * 8);
#pragma unroll
                    for (int i = 0; i < 8; ++i) {
                        const bf16x8 k0 = *(const LAS bf16x8*)(Ks + r32 * KP + (dc + i) * 16 + hi * 8);
                        const bf16x8 k1 = *(const LAS bf16x8*)(Ks + (32 + r32) * KP + (dc + i) * 16 + hi * 8);
                        p0 = MFMA32(k0, q4[i], p0); p1 = MFMA32(k1, q4[i], p1);
                    }
                }
            }
            if (CAUSAL && (64 * t + 63 > qpos0)) {
                const int qp = qpos0 + r32;
#pragma unroll
                for (int r = 0; r < 16; ++r) { const int kv = 64 * t + crow(r, hi); if (kv > qp) p0[r] = -1e30f; if (kv + 32 > qp) p1[r] = -1e30f; }
            }
            float mt = fmaxf(p0[0], p1[0]);
#pragma unroll
            for (int r = 1; r < 16; ++r) mt = fmaxf(mt, fmaxf(p0[r], p1[r]));
            mt = fmaxf(mt, __shfl_xor(mt, 32));
            const bool grow = __any(mt > mrun + 8.0f / cscale);
            float alpha = 1.0f;
            if (grow) { const float mn = fmaxf(mrun, mt); alpha = __builtin_amdgcn_exp2f((mrun - mn) * cscale); mrun = mn; }
            const float mnc = -mrun * cscale;
            float rs = 0.f;
#pragma unroll
            for (int r = 0; r < 16; ++r) { p0[r] = __builtin_amdgcn_exp2f(__builtin_fmaf(p0[r], cscale, mnc)); p1[r] = __builtin_amdgcn_exp2f(__builtin_fmaf(p1[r], cscale, mnc)); rs += p0[r] + p1[r]; }
            lrun = lrun * alpha + rs;
            if (grow) {
                if (hi == 0) wsf[r32] = alpha;
                asm volatile("s_waitcnt lgkmcnt(0)" ::: "memory");
#pragma unroll
                for (int r = 0; r < 16; ++r) { const float a = wsf[crow(r, hi)];
#pragma unroll
                    for (int eb = 0; eb < 4; ++eb) o[eb][r] *= a; }
            }
#pragma unroll
            for (int half = 0; half < 2; ++half)
#pragma unroll
                for (int rr = 0; rr < 2; ++rr) {
                    u32x4 pw;
                    if (half == 0) { pw.x = pk2(p0[8 * rr + 0], p0[8 * rr + 1]); pw.y = pk2(p0[8 * rr + 2], p0[8 * rr + 3]); pw.z = pk2(p0[8 * rr + 4], p0[8 * rr + 5]); pw.w = pk2(p0[8 * rr + 6], p0[8 * rr + 7]); }
                    else           { pw.x = pk2(p1[8 * rr + 0], p1[8 * rr + 1]); pw.y = pk2(p1[8 * rr + 2], p1[8 * rr + 3]); pw.z = pk2(p1[8 * rr + 4], p1[8 * rr + 5]); pw.w = pk2(p1[8 * rr + 6], p1[8 * rr + 7]); }
                    const bf16x8 pa = __builtin_bit_cast(bf16x8, pw);
#pragma unroll
                    for (int eb = 0; eb < 4; ++eb) {
                        const bf16x8 vb = *(const LAS bf16x8*)(Vs + (32 * eb + r32) * 72 + 32 * half + 16 * rr + 8 * hi);
                        o[eb] = MFMA32(pa, vb, o[eb]);
                    }
                }
        }
        if (t + 1 < NT) {
            LAS bf16_t* Kn = (LAS bf16_t*)(lds + ((t + 1) & 1) * BUFB); LAS bf16_t* Vn = (LAS bf16_t*)(lds + ((t + 1) & 1) * BUFB + KSB);
            if (!PREFETCH) {
#pragma unroll
                for (int i = 0; i < KL; ++i) { const int ci = tid + NTHREADS * i, row = ci / KC, cc = ci % KC; kst[i] = *(const u32x4*)(Kbase + (size_t)(64 * (t + 1) + row) * kpitch + cc * 8); }
#pragma unroll
                for (int i = 0; i < 2; ++i) { const int ci = tid + NTHREADS * i, e = ci >> 3, cc = ci & 7; vst[i] = *(const u32x4*)(VTbase + (size_t)e * vpitch + 64 * (t + 1) + cc * 8); }
            }
#pragma unroll
            for (int i = 0; i < KL; ++i) { const int ci = tid + NTHREADS * i, row = ci / KC, cc = ci % KC; *(LAS u32x4*)(Kn + row * KP + cc * 8) = kst[i]; }
#pragma unroll
            for (int i = 0; i < 2; ++i) { const int ci = tid + NTHREADS * i, e = ci >> 3, cc = ci & 7; { LAS bf16_t* vd = Vn + e * 72 + (cc >> 1) * 16 + (cc & 1) * 4; *(LAS u32x2*)vd = (u32x2){vst[i].x, vst[i].y}; *(LAS u32x2*)(vd + 8) = (u32x2){vst[i].z, vst[i].w}; } }
        }
        __syncthreads();
    }
    lrun += __shfl_xor(lrun, 32);
    if (hi == 0) wsf[r32] = __builtin_amdgcn_rcpf(lrun);
    asm volatile("s_waitcnt lgkmcnt(0)" ::: "memory");
#pragma unroll
    for (int r = 0; r < 16; ++r) { const float a = wsf[crow(r, hi)];
#pragma unroll
        for (int eb = 0; eb < 4; ++eb) o[eb][r] *= a; }
    asm volatile("s_waitcnt lgkmcnt(0)" ::: "memory");
}

__device__ __forceinline__ void diffattn_unit(int b, int h, int qb, const bf16_t* Q, const bf16_t* Kb, const bf16_t* VT, bf16_t* O, float lam, const float* subg, LAS unsigned char* lds, int wid, int lane) {
    const int r32 = lane & 31, hi = lane >> 5;
    const int q0 = 256 * qb, qpos0 = q0 + 32 * wid;
    const size_t trow = (size_t)b * SEQ_ + qpos0 + r32;
    const int NT = 4 * (qb + 1);
    const float cs = 0.125f * 1.4426950408889634f;
    f32x16 o1[4];
    flash_pass<64, true, true>(o1, Q + trow * 1024 + h * 128, Kb + (size_t)b * SEQ_ * 1024 + h * 128, 1024, VT + (size_t)(h * 128) * T_ + (size_t)b * SEQ_, T_, NT, qpos0, cs, lds, wid, lane);
    volatile LAS unsigned* st = (volatile LAS unsigned*)(lds + 57344) + wid * 2048 + lane;
#pragma unroll
    for (int r = 0; r < 16; ++r) { st[(2 * r) * 64] = pk2(o1[0][r], o1[1][r]); st[(2 * r + 1) * 64] = pk2(o1[2][r], o1[3][r]); }
    flash_pass<64, true, true>(o1, Q + trow * 1024 + h * 128 + 64, Kb + (size_t)b * SEQ_ * 1024 + h * 128 + 64, 1024, VT + (size_t)(h * 128) * T_ + (size_t)b * SEQ_, T_, NT, qpos0, cs, lds, wid, lane);
    float gsub[4];
#pragma unroll
    for (int eb = 0; eb < 4; ++eb) gsub[eb] = subg[32 * eb + r32] * 0.8f;
#pragma unroll
    for (int r = 0; r < 16; ++r) {
        const unsigned w0 = st[(2 * r) * 64], w1 = st[(2 * r + 1) * 64];
        float v[4] = {bflo(w0) - lam * o1[0][r], bfhi(w0) - lam * o1[1][r], bflo(w1) - lam * o1[2][r], bfhi(w1) - lam * o1[3][r]};
        float ss = (v[0] * v[0] + v[1] * v[1]) + (v[2] * v[2] + v[3] * v[3]);
#pragma unroll
        for (int off = 1; off < 32; off <<= 1) ss += __shfl_xor(ss, off);
        const float rs = __builtin_amdgcn_rsqf(ss * (1.f / 128.f) + 1e-5f);
        bf16_t* orow = O + ((size_t)b * SEQ_ + qpos0 + crow(r, hi)) * 1024 + h * 128 + r32;
#pragma unroll
        for (int eb = 0; eb < 4; ++eb) orow[32 * eb] = bf1(v[eb] * rs * gsub[eb]);
    }
}
__device__ __forceinline__ void xattn_unit(int b, int h, int qb, int dh, const bf16_t* QX, const bf16_t* KX, const bf16_t* VXT, bf16_t* XO, LAS unsigned char* lds, int wid, int lane) {
    const int r32 = lane & 31, hi = lane >> 5;
    const int qpos0 = 256 * qb + 32 * wid;
    const size_t trow = (size_t)b * SEQ_ + qpos0 + r32;
    f32x16 o[4];
    flash_pass<256, false, true>(o, QX + trow * 1024 + h * 256, KX + (size_t)b * 256 * 1024 + h * 256, 1024, VXT + (size_t)(h * 256 + dh * 128) * MEMT_ + b * 256, MEMT_, 4, 0, 0.0625f * 1.4426950408889634f, lds, wid, lane);
#pragma unroll
    for (int r = 0; r < 16; ++r) {
        bf16_t* orow = XO + ((size_t)b * SEQ_ + qpos0 + crow(r, hi)) * 1024 + h * 256 + dh * 128 + r32;
#pragma unroll
        for (int eb = 0; eb < 4; ++eb) orow[32 * eb] = bf1(o[eb][r]);
    }
}

constexpr int SP = 136;
constexpr int SOFF_BM = 0, SOFF_BT = 34816, SOFF_CM = 69632, SOFF_XT = 104448, SOFF_SB = 121856, SOFF_F = 139264, SOFF_CW = 141824;
template <int STR>
__device__ __forceinline__ void conv8(const u32x4 (&u)[4], const LAS float* cwb, float (&out)[8]) {
#pragma unroll
    for (int k = 0; k < 8; ++k) {
        float acc = cwb[(k * 5 + 4) * STR];
#pragma unroll
        for (int j = 0; j < 4; ++j) { const unsigned w = (k >> 1) == 0 ? u[j].x : (k >> 1) == 1 ? u[j].y : (k >> 1) == 2 ? u[j].z : u[j].w; const float v = (k & 1) ? bfhi(w) : bflo(w); acc += cwb[(k * 5 + j) * STR] * v; }
        out[k] = acc * fsigm(acc);
    }
}
__device__ __forceinline__ void ssd_unit(int b, int h, const bf16_t* XS, const bf16_t* BC, bf16_t* Z, const float* dtT, const float* conv_w, const float* conv_b, const float* A_log, const float* Dp, LAS unsigned char* lds, int wid, int lane) {
    const int tid = threadIdx.x, r32 = lane & 31, hi = lane >> 5, g = h >> 3;
    LAS bf16_t* Bm = (LAS bf16_t*)(lds + SOFF_BM); LAS bf16_t* BT = (LAS bf16_t*)(lds + SOFF_BT); LAS bf16_t* Cm = (LAS bf16_t*)(lds + SOFF_CM);
    LAS bf16_t* XT = (LAS bf16_t*)(lds + SOFF_XT); LAS bf16_t* Sb = (LAS bf16_t*)(lds + SOFF_SB);
    LAS float* acs = (LAS float*)(lds + SOFF_F); LAS float* dec = acs + 128; LAS float* eacs = acs + 256; LAS float* ddt = acs + 384; LAS float* cw = (LAS float*)(lds + SOFF_CW);
    const float a_h = -__expf(A_log[h]), D_h = Dp[h];
    for (int i = tid; i < 1600; i += NTHREADS) {
        int ci, kj;
        if (i < 320) { kj = i >> 3; ci = (i & 7) * 8 + kj / 5; } else if (i < 960) { const int q = i - 320; kj = q >> 4; ci = 64 + (q & 15) * 8 + kj / 5; } else { const int q = i - 960; kj = q >> 4; ci = 192 + (q & 15) * 8 + kj / 5; }
        const int j = kj % 5; const int ch = ci < 64 ? h * 64 + ci : ci < 192 ? 2048 + g * 128 + (ci - 64) : 2560 + g * 128 + (ci - 192);
        cw[i] = j < 4 ? conv_w[j * 3072 + ch] : conv_b[ch]; }
    for (int i = tid; i < 64 * SP / 2; i += NTHREADS) ((LAS unsigned*)Sb)[i] = 0u;
    f32x16 S;
#pragma unroll
    for (int r = 0; r < 16; ++r) S[r] = 0.f;
    __syncthreads();
    float dn0 = dtT[(size_t)h * T_ + (size_t)b * SEQ_ + 2 * lane], dn1 = dtT[(size_t)h * T_ + (size_t)b * SEQ_ + 2 * lane + 1];
    for (int c = 0; c < 32; ++c) {
        const int s0 = 128 * c; const size_t t0 = (size_t)b * SEQ_ + s0;
        if (wid == 0) {
            const float d0 = dn0, d1 = dn1;
            if (c + 1 < 32) { dn0 = dtT[(size_t)h * T_ + t0 + 128 + 2 * lane]; dn1 = dtT[(size_t)h * T_ + t0 + 128 + 2 * lane + 1]; }
            const float a0 = a_h * d0, a1 = a_h * d1; const float pr = a0 + a1; float inc = pr;
#pragma unroll
            for (int off = 1; off < 64; off <<= 1) { const float n = __shfl_up(inc, off); if (lane >= off) inc += n; }
            const float exc = inc - pr, tot = __shfl(inc, 63);
            const float c0 = exc + a0, c1 = inc;
            acs[2 * lane] = c0; acs[2 * lane + 1] = c1; dec[2 * lane] = __expf(tot - c0); dec[2 * lane + 1] = __expf(tot - c1);
            eacs[2 * lane] = __expf(c0); eacs[2 * lane + 1] = __expf(c1); ddt[2 * lane] = D_h / fmaxf(d0, 1e-30f); ddt[2 * lane + 1] = D_h / fmaxf(d1, 1e-30f);
        }
        {
            u32x4 wb[4], wc_[4];
#pragma unroll
            for (int i = 0; i < 4; ++i) { const int item = tid + NTHREADS * i, l = item >> 4, n8 = item & 15; const bf16_t* p = BC + (t0 + l) * 1024 + g * 128 + n8 * 8; wb[i] = *(const u32x4*)p; wc_[i] = *(const u32x4*)(p + 512); }
#pragma unroll
            for (int i = 0; i < 4; ++i) { const int item = tid + NTHREADS * i, l = item >> 4, n8 = item & 15;
                *(LAS u32x4*)(Bm + l * SP + n8 * 8) = wb[i]; *(LAS u32x4*)(Cm + l * SP + n8 * 8) = wc_[i];
                const unsigned short e[8] = {(unsigned short)(wb[i].x & 0xffffu), (unsigned short)(wb[i].x >> 16), (unsigned short)(wb[i].y & 0xffffu), (unsigned short)(wb[i].y >> 16),
                                             (unsigned short)(wb[i].z & 0xffffu), (unsigned short)(wb[i].z >> 16), (unsigned short)(wb[i].w & 0xffffu), (unsigned short)(wb[i].w >> 16)};
#pragma unroll
                for (int k = 0; k < 8; ++k) BT[(n8 * 8 + k) * SP + (l ^ (n8 << 3))] = e[k]; }
        }
        {
            u32x4 ux[2][4]; float dtl[2];
#pragma unroll
            for (int i = 0; i < 2; ++i) { const int item = tid + NTHREADS * i, l = item >> 3, p8 = item & 7;
                dtl[i] = dtT[(size_t)h * T_ + t0 + l];
#pragma unroll
                for (int j = 0; j < 4; ++j) { const int sp = s0 + l - 3 + j;
                    if (sp >= 0) ux[i][j] = *(const u32x4*)(XS + (t0 + l - 3 + j) * 2048 + h * 64 + p8 * 8); else ux[i][j] = (u32x4){0u, 0u, 0u, 0u}; } }
#pragma unroll
            for (int i = 0; i < 2; ++i) { const int item = tid + NTHREADS * i, l = item >> 3, p8 = item & 7;
                float vx[8]; conv8<8>(ux[i], cw + p8, vx);
#pragma unroll
                for (int k = 0; k < 8; ++k) XT[(p8 * 8 + k) * SP + (l ^ (p8 << 3))] = bf1(vx[k] * dtl[i]); }
        }
        __syncthreads();
        f32x16 cb[2];
#pragma unroll
        for (int q = 0; q < 2; ++q) {
            const int idx = wid + 8 * q;
            if (idx < 10) {
                const int lb = idx < 1 ? 0 : idx < 3 ? 1 : idx < 6 ? 2 : 3; const int sb = idx - (lb * (lb + 1)) / 2;
                f32x16 acc;
#pragma unroll
                for (int r = 0; r < 16; ++r) acc[r] = 0.f;
#pragma unroll
                for (int kk = 0; kk < 8; ++kk) { const bf16x8 af = *(const LAS bf16x8*)(Cm + (32 * lb + r32) * SP + 16 * kk + 8 * hi); const bf16x8 bfm = *(const LAS bf16x8*)(Bm + (32 * sb + r32) * SP + 16 * kk + 8 * hi); acc = MFMA32(af, bfm, acc); }
                const int s = 32 * sb + r32; const float as = acs[s];
#pragma unroll
                for (int r = 0; r < 16; ++r) { const int l = 32 * lb + crow(r, hi); const float e = __expf(fminf(acs[l] - as, 0.f)); acc[r] = l >= s ? acc[r] * e : 0.f; }
                cb[q] = acc;
            }
        }
        __syncthreads();
#pragma unroll
        for (int q = 0; q < 2; ++q) {
            const int idx = wid + 8 * q;
            if (idx < 10) {
                const int lb = idx < 1 ? 0 : idx < 3 ? 1 : idx < 6 ? 2 : 3; const int sb = idx - (lb * (lb + 1)) / 2;
#pragma unroll
                for (int r = 0; r < 16; ++r) Bm[(32 * lb + crow(r, hi)) * SP + 32 * sb + r32] = bf1(cb[q][r]);
            }
        }
        __syncthreads();
        {
            const int lb = wid >> 1, pb = wid & 1;
            f32x16 acc;
#pragma unroll
            for (int r = 0; r < 16; ++r) acc[r] = 0.f;
#pragma unroll
            for (int kk = 0; kk < 8; ++kk) { const bf16x8 af = *(const LAS bf16x8*)(Cm + (32 * lb + r32) * SP + 16 * kk + 8 * hi); const bf16x8 bfm = *(const LAS bf16x8*)(Sb + (32 * pb + r32) * SP + 16 * kk + 8 * hi); acc = MFMA32(af, bfm, acc); }
#pragma unroll
            for (int r = 0; r < 16; ++r) acc[r] *= eacs[32 * lb + crow(r, hi)];
            for (int sb = 0; sb <= lb; ++sb)
#pragma unroll
                for (int k2 = 0; k2 < 2; ++k2) { const bf16x8 af = *(const LAS bf16x8*)(Bm + (32 * lb + r32) * SP + 32 * sb + 16 * k2 + 8 * hi); const bf16x8 bfm = *(const LAS bf16x8*)(XT + (32 * pb + r32) * SP + ((32 * sb + 16 * k2 + 8 * hi) ^ (((32 * pb + r32) >> 3) << 3))); acc = MFMA32(af, bfm, acc); }
#pragma unroll
            for (int rg = 0; rg < 4; ++rg) { const int l = 32 * lb + 8 * rg + 4 * hi; const u32x2 xw = *(const LAS u32x2*)(XT + (32 * pb + r32) * SP + (l ^ (((32 * pb + r32) >> 3) << 3)));
                acc[4 * rg + 0] += ddt[l + 0] * bflo(xw.x); acc[4 * rg + 1] += ddt[l + 1] * bfhi(xw.x); acc[4 * rg + 2] += ddt[l + 2] * bflo(xw.y); acc[4 * rg + 3] += ddt[l + 3] * bfhi(xw.y); }
            unsigned short zr[16];
#pragma unroll
            for (int r = 0; r < 16; ++r) zr[r] = Z[(t0 + 32 * lb + crow(r, hi)) * 2048 + h * 64 + 32 * pb + r32];
#pragma unroll
            for (int r = 0; r < 16; ++r) { const float zv = bf2f(zr[r]); Z[(t0 + 32 * lb + crow(r, hi)) * 2048 + h * 64 + 32 * pb + r32] = bf1(acc[r] * zv * fsigm(zv)); }
        }
        {
            const int pb = wid >> 2, nb = wid & 3; const float etot = eacs[127];
#pragma unroll
            for (int r = 0; r < 16; ++r) S[r] *= etot;
#pragma unroll 2
            for (int kk = 0; kk < 8; ++kk) {
                const u32x4 xw = *(const LAS u32x4*)(XT + (32 * pb + r32) * SP + ((16 * kk + 8 * hi) ^ (((32 * pb + r32) >> 3) << 3))); const LAS float* dp = dec + 16 * kk + 8 * hi;
                u32x4 aw; aw.x = pk2(bflo(xw.x) * dp[0], bfhi(xw.x) * dp[1]); aw.y = pk2(bflo(xw.y) * dp[2], bfhi(xw.y) * dp[3]); aw.z = pk2(bflo(xw.z) * dp[4], bfhi(xw.z) * dp[5]); aw.w = pk2(bflo(xw.w) * dp[6], bfhi(xw.w) * dp[7]);
                const bf16x8 bfm = *(const LAS bf16x8*)(BT + (32 * nb + r32) * SP + ((16 * kk + 8 * hi) ^ (((32 * nb + r32) >> 3) << 3)));
                S = MFMA32(__builtin_bit_cast(bf16x8, aw), bfm, S);
            }
            __syncthreads();
#pragma unroll
            for (int r = 0; r < 16; ++r) Sb[(32 * pb + crow(r, hi)) * SP + 32 * nb + r32] = bf1(S[r]);
        }
    }
    __syncthreads();
}

struct PairOrder {
    pg8::StaticOrder base;
    __device__ __forceinline__ bool next(int i, pg8::Unit& u) const { if (!base.next(i >> 1, u)) return false; u.pn += 4 * (i & 1); return true; }
    __device__ __forceinline__ void a_ready(const pg8::Unit&) const {}
    __device__ __forceinline__ void done(const pg8::Unit&) const {}
};
#define XB_USE 1
typedef unsigned v4u_unused_t;
#define XB_TMO      128
#define XB_XCNT(j)  (256  + 64 * (j))
#define XB_XSUB(j)  (1280 + 64 * (j))
#define XB_XGEN(j)  (2304 + 64 * (j))
#define XB_TOP      3328
#define XB_TOPGEN   3392
#define XCD_BAR_WORDS 3456
#define XB_SPIN_CAP (1u << 18)

__device__ __forceinline__ unsigned xb_ld(unsigned* p)              { return __hip_atomic_load(p, __ATOMIC_RELAXED, __HIP_MEMORY_SCOPE_AGENT); }
__device__ __forceinline__ unsigned xb_add(unsigned* p, unsigned v) { return __hip_atomic_fetch_add(p, v, __ATOMIC_RELAXED, __HIP_MEMORY_SCOPE_AGENT); }
__device__ __forceinline__ unsigned xb_xcc_id() { return (unsigned)__builtin_amdgcn_s_getreg((3 << 11) | 20) & 0xFu; }
#define XB_SPIN(cond, bar) do { unsigned _sp = 0; while (cond) { __builtin_amdgcn_s_sleep(1); \
    if ((++_sp & 255u) == 0u) { if (xb_ld(&(bar)[XB_TMO])) break; if (_sp > XB_SPIN_CAP) { atomicAdd(&(bar)[XB_TMO], 1u); break; } } } } while (0)

struct XcdBarrier {
    unsigned* bar; unsigned x;
    volatile LAS unsigned* st;
};

__device__ __forceinline__ XcdBarrier xcd_barrier_post(unsigned* bar, volatile LAS unsigned* st) {
    XcdBarrier b; b.bar = bar; b.x = xb_xcc_id(); b.st = st;
    if (threadIdx.x == 0) (void)xb_add(&bar[XB_XCNT(b.x)], 1u);
    return b;
}
__device__ __forceinline__ void xcd_barrier_complete(unsigned* bar, unsigned x, unsigned& nloc, unsigned& nx) {
    const unsigned G = gridDim.x * gridDim.y * gridDim.z;
    unsigned sum, cnt, mine, sp = 0u;
    for (;;) {
        sum = 0u; cnt = 0u; mine = 0u;
#pragma unroll
        for (unsigned j = 0; j < 16; ++j) { const unsigned c = xb_ld(&bar[XB_XCNT(j)]); sum += c; cnt += (c > 0u) ? 1u : 0u; mine = (j == x) ? c : mine; }
        if (sum == G) break;
        __builtin_amdgcn_s_sleep(1);
        if ((++sp & 255u) == 0u) { if (xb_ld(&bar[XB_TMO])) break; if (sp > XB_SPIN_CAP) { atomicAdd(&bar[XB_TMO], 1u); break; } }
    }
    nloc = mine > 0u ? mine : 1u; nx = cnt > 0u ? cnt : 1u;
}

__device__ __forceinline__ void xcd_barrier(const XcdBarrier& b) {
    asm volatile("s_waitcnt vmcnt(0)" ::: "memory");
    __syncthreads();
    if (threadIdx.x == 0) {
        unsigned* bar = b.bar;
        __builtin_amdgcn_s_waitcnt(0);
        unsigned nloc = b.st[0], nx = b.st[1];
        if (nloc == 0u) { xcd_barrier_complete(bar, b.x, nloc, nx); b.st[0] = nloc; b.st[1] = nx; }
        const unsigned old = xb_add(&bar[XB_XSUB(b.x)], 1u);
        const unsigned gen = old / nloc;
        if (old + 1u == (gen + 1u) * nloc) {
            __builtin_amdgcn_fence(__ATOMIC_RELEASE, "agent");
            asm volatile("s_waitcnt vmcnt(0)" ::: "memory");
            const unsigned og = xb_add(&bar[XB_TOP], 1u);
            const unsigned tg = og / nx;
            if (og + 1u == (tg + 1u) * nx) xb_add(&bar[XB_TOPGEN], 1u);
            else XB_SPIN(xb_ld(&bar[XB_TOPGEN]) == tg, bar);
            __builtin_amdgcn_fence(__ATOMIC_ACQUIRE, "agent");
            xb_add(&bar[XB_XGEN(b.x)], 1u);
            asm volatile("s_waitcnt vmcnt(0)" ::: "memory");
        } else {
            XB_SPIN(xb_ld(&bar[XB_XGEN(b.x)]) == gen, bar);
            __builtin_amdgcn_fence(__ATOMIC_ACQUIRE, "agent");
            asm volatile("s_waitcnt vmcnt(0)" ::: "memory");
        }
    }
    __syncthreads();
}

struct Args { const float* in[34]; float* out; unsigned char* ws; int ph_lo, ph_hi; };
constexpr int N_PHASES = 19;

__global__ void __launch_bounds__(NTHREADS, 2) mk_fwd(Args a) {
    extern __shared__ __attribute__((aligned(16))) unsigned char lds_raw[];
    LAS unsigned char* lds = (LAS unsigned char*)lds_raw;
    cg::grid_group grid = cg::this_grid();
    { volatile LAS unsigned* xst = (volatile LAS unsigned*)(lds + 155632);
      if (threadIdx.x == 0) { xst[0] = 0u; xst[1] = 0u; }
      __syncthreads();
      (void)xcd_barrier_post((unsigned*)(a.ws + 8192), xst); }
    grid.sync();
    const int G = gridDim.x, bx = blockIdx.x;
#define PH_IDS int tid; asm volatile("v_mov_b32 %0, %1" : "=v"(tid) : "v"(threadIdx.x)); const int lane = tid & 63, wid = __builtin_amdgcn_readfirstlane(tid >> 6); \
    const int vcu = (G % 8 == 0) ? (bx % 8) * (G / 8) + bx / 8 : bx; const int gw = vcu * NWAVES + wid, NGW = G * NWAVES; (void)lane; (void)gw; (void)NGW; \
    LAS float* scr = (LAS float*)(lds + wid * 16384); (void)scr; \
    const float* const* INP; { const void* kp_ = (const void*)__builtin_amdgcn_kernarg_segment_ptr(); asm volatile("" : "=s"(INP) : "0"(kp_)); } (void)INP;
    unsigned char* ws = a.ws;
    float* out = a.out; bf16_t* RB = (bf16_t*)a.out + (size_t)T_ * DM_;
    bf16_t* ABUF = (bf16_t*)(ws + WS_ABUF);
#define IN(k) (a.ph_lo <= (k) && (k) < a.ph_hi)
#define GSYNC_W(woff_, target_) do { XcdBarrier xb_; xb_.bar = (unsigned*)(a.ws + 8192); xb_.x = xb_xcc_id(); xb_.st = (volatile LAS unsigned*)(lds + 155632); \
    asm volatile("s_waitcnt vmcnt(0) lgkmcnt(0)" ::: "memory"); xcd_barrier(xb_); } while (0)
#define GSYNC(k) GSYNC_W(0, (k) + 1 - a.ph_lo - (((k) > 12 && a.ph_lo <= 12) ? 1 : 0))
#define SEAM(k) do { if (a.ph_lo <= (k) && (k) + 1 < a.ph_hi) GSYNC(k); } while (0)
    using namespace pg8;

    if (IN(0)) { PH_IDS
        int itb = 0;
        tr_job(INP[4], DM_, 2 * DFF_, 0, 2 * DFF_, (bf16_t*)(ws + WS_WGU), 1, scr, gw, NGW, lane, itb);
        if (G < 256) tr_job(INP[5], DFF_, DM_, 0, DM_, (bf16_t*)(ws + WS_WD), 0, scr, gw, NGW, lane, itb);
        tr_job(INP[8], DM_, 10272, 0, 8224, (bf16_t*)(ws + WS_WIN), 0, scr, gw, NGW, lane, itb);
        tr_job(INP[28], DM_, 2048, 0, 2048, (bf16_t*)(ws + WS_WKV), 0, scr, gw, NGW, lane, itb);
        rowwise<false, false>(nullptr, INP[0], nullptr, 0.f, nullptr, INP[2], ABUF, T_, gw, NGW, lane);
        rowwise<false, false>(nullptr, INP[1], nullptr, 0.f, nullptr, INP[26], (bf16_t*)(ws + WS_MEMN), MEMT_, gw, NGW, lane);
    }
    SEAM(0);
    if (IN(1)) { PH_IDS
        { Gemm g{ABUF, (const bf16_t*)(ws + WS_WGU), T_, 2 * DFF_, DM_}; StaticOrder S; S.init(T_, 2 * DFF_, G, bx); EpiSwiglu E{(bf16_t*)(ws + WS_HBUF), DFF_};
          gemm_phase<EpiSwiglu, StaticOrder, true, true>(lds, g, S, E); }
        { Gemm g{(const bf16_t*)(ws + WS_MEMN), (const bf16_t*)(ws + WS_WKV), MEMT_, 1024, DM_}; StaticOrder S; S.init(MEMT_, 1024, G, (bx + 112) % G); EpiB<0> E{(bf16_t*)(ws + WS_KX), 1024, nullptr, 0, 0};
          gemm_phase<EpiB<0>, StaticOrder, true, true>(lds, g, S, E); }
        { Gemm g{(const bf16_t*)(ws + WS_WKV) + (size_t)1024 * 1024, (const bf16_t*)(ws + WS_MEMN), 1024, MEMT_, DM_}; StaticOrder S; S.init(1024, MEMT_, G, (bx + 128) % G); EpiB<0> E{(bf16_t*)(ws + WS_VXT), MEMT_, nullptr, 0, 0};
          gemm_phase<EpiB<0>, StaticOrder, true, true>(lds, g, S, E); }
            if (G >= 256 && bx >= 128) {
            int tid2; asm volatile("v_mov_b32 %0, %1" : "=v"(tid2) : "v"(threadIdx.x)); const int lane2 = tid2 & 63, wid2 = __builtin_amdgcn_readfirstlane(tid2 >> 6);
            int itb2 = 0; tr_job(INP[5], DFF_, DM_, 0, DM_, (bf16_t*)(ws + WS_WD), 0, (LAS float*)(lds + wid2 * 16384), (bx - 128) * NWAVES + wid2, (G - 128) * NWAVES, lane2, itb2);
        }
    }
    SEAM(1);
    if (IN(2)) { PH_IDS
        Gemm g{(const bf16_t*)(ws + WS_HBUF), (const bf16_t*)(ws + WS_WD), T_, DM_, DFF_}; StaticOrder S; S.init(T_, DM_, G, bx); EpiB<0> E{(bf16_t*)(ws + WS_YBUF_A), DM_, nullptr, 0, 0};
        gemm_phase<EpiB<0>, StaticOrder, true, true>(lds, g, S, E);
    }
    SEAM(2);
    if (IN(3)) { PH_IDS rowwise<false, true>((const bf16_t*)(ws + WS_YBUF_A), INP[0], INP[3], 0.5f, RB, INP[6], ABUF, T_, gw, NGW, lane); }
    SEAM(3);
    if (IN(4)) { PH_IDS
        { Gemm g{ABUF, (const bf16_t*)(ws + WS_WIN), T_, 2048, DM_}; StaticOrder S; S.init(T_, 2048, G, bx); EpiB<0> E{(bf16_t*)(ws + WS_Q), 1024, nullptr, 1024, (WS_K - WS_Q) / 2};
          gemm_phase<EpiB<0>, StaticOrder, true, true>(lds, g, S, E); }
        { Gemm g{(const bf16_t*)(ws + WS_WIN) + (size_t)2048 * 1024, ABUF, 1024, T_, DM_}; StaticOrder S; S.init(1024, T_, G, bx); EpiB<0> E{(bf16_t*)(ws + WS_VT), T_, nullptr, 0, 0};
          gemm_phase<EpiB<0>, StaticOrder, true, true>(lds, g, S, E); }
    }
    SEAM(4);
    if (IN(5)) { PH_IDS
        const float v1 = INP[10][lane] * INP[11][lane], v2 = INP[12][lane] * INP[13][lane];
        const float lam = __expf(wave_sum(v1)) - __expf(wave_sum(v2)) + 0.2f;
        for (int u = vcu; u < 512; u += G) {
            const int v = u & 255, bh = v >> 3, qb = u < 256 ? (v & 7) : 15 - (v & 7);
            diffattn_unit(bh >> 3, bh & 7, qb, (const bf16_t*)(ws + WS_Q), (const bf16_t*)(ws + WS_K), (const bf16_t*)(ws + WS_VT), (bf16_t*)(ws + WS_Q), lam, INP[14], lds, wid, lane);
        }
    }
    SEAM(5);
    if (IN(6)) { PH_IDS
        Gemm g{ABUF, (const bf16_t*)(ws + WS_WIN) + (size_t)3072 * 1024, T_, 5120, DM_}; StaticOrder S; S.init(T_, 5120, G, bx);
        EpiInB E{(bf16_t*)(ws + WS_Z), (bf16_t*)(ws + WS_XS), (bf16_t*)(ws + WS_BC), (float*)(ws + WS_DTT), INP[17], T_};
        gemm_phase<EpiInB, StaticOrder, true, true>(lds, g, S, E);
        if (gw < T_ / 32) {
            const int r32 = lane & 31, hi = lane >> 5; const size_t row0 = (size_t)gw * 32;
            const bf16_t* ap = ABUF + (row0 + r32) * DM_ + 8 * hi; const bf16_t* bp = (const bf16_t*)(ws + WS_WIN) + (size_t)(8192 + r32) * 1024 + 8 * hi;
            f32x16 acc;
#pragma unroll
            for (int r = 0; r < 16; ++r) acc[r] = 0.f;
#pragma unroll 8
            for (int kk = 0; kk < 64; ++kk) acc = MFMA32(*(const bf16x8*)(ap + 16 * kk), *(const bf16x8*)(bp + 16 * kk), acc);
            const float bias = INP[17][r32]; float* dtT = (float*)(ws + WS_DTT);
#pragma unroll
            for (int r = 0; r < 16; ++r) { const float xv = acc[r] + bias; dtT[(size_t)r32 * T_ + row0 + crow(r, hi)] = xv > 20.f ? xv : log1pf(__expf(xv)); }
        }
        GSYNC_W(32, 1);
        { const int gt = gw * 64 + lane, cg = gt & 127, run = gt >> 7; bf16_t* base = (bf16_t*)(ws + WS_BC) + (size_t)run * 16 * 1024 + cg * 8;
          u32x4 rw[19];
#pragma unroll
          for (int j = 0; j < 3; ++j) rw[j] = ((run * 16) % SEQ_ == 0) ? (u32x4){0u, 0u, 0u, 0u} : *(const u32x4*)(base - (size_t)(3 - j) * 1024);
          GSYNC_W(32, 2);
#pragma unroll
          for (int j = 0; j < 16; ++j) rw[3 + j] = *(const u32x4*)(base + (size_t)j * 1024);
          float wv[8][5];
#pragma unroll
          for (int k = 0; k < 8; ++k) {
#pragma unroll
              for (int j = 0; j < 4; ++j) wv[k][j] = INP[15][j * 3072 + 2048 + cg * 8 + k];
              wv[k][4] = INP[16][2048 + cg * 8 + k]; }
#pragma unroll
          for (int i = 0; i < 16; ++i) { float o[8];
#pragma unroll
              for (int k = 0; k < 8; ++k) { float acc = wv[k][4];
#pragma unroll
                  for (int j = 0; j < 4; ++j) { const u32x4 r4 = rw[i + j]; const unsigned w = (k >> 1) == 0 ? r4.x : (k >> 1) == 1 ? r4.y : (k >> 1) == 2 ? r4.z : r4.w; acc += wv[k][j] * ((k & 1) ? bfhi(w) : bflo(w)); }
                  o[k] = acc * fsigm(acc); }
              u32x4 ov; ov.x = pk2(o[0], o[1]); ov.y = pk2(o[2], o[3]); ov.z = pk2(o[4], o[5]); ov.w = pk2(o[6], o[7]);
              *(u32x4*)(base + (size_t)i * 1024) = ov; }
        }
    }
    SEAM(6);
    if (IN(7)) { PH_IDS
        const int ssd_u = (G >= 256) ? (((vcu & 31) < 16) ? (vcu >> 5) * 16 + (vcu & 31) : 128) : vcu;
        for (int u = ssd_u; u < 128; u += G)
            ssd_unit(u >> 5, u & 31, (const bf16_t*)(ws + WS_XS), (const bf16_t*)(ws + WS_BC), (bf16_t*)(ws + WS_Z), (const float*)(ws + WS_DTT), INP[15], INP[16], INP[18], INP[19], lds, wid, lane);
            if (G >= 256 && (vcu & 31) >= 16) {
            int tid2; asm volatile("v_mov_b32 %0, %1" : "=v"(tid2) : "v"(threadIdx.x)); const int lane = tid2 & 63;
            const int gw2 = ((vcu >> 5) * 16 + (vcu & 31) - 16) * NWAVES + wid, NGW2 = (G - 128) * NWAVES; int itb = 0;
            tr_job(INP[8], DM_, 10272, 8224, 2048, (bf16_t*)(ws + WS_WG), 0, scr, gw2, NGW2, lane, itb);
            tr_job(INP[21], DM_, DM_, 0, DM_, (bf16_t*)(ws + WS_WBA), 0, scr, gw2, NGW2, lane, itb);
            tr_job(INP[22], 2048, DM_, 0, DM_, (bf16_t*)(ws + WS_WBS), 0, scr, gw2, NGW2, lane, itb);
            tr_job(INP[23], DM_, DM_, 0, DM_, (bf16_t*)(ws + WS_WMO), 0, scr, gw2, NGW2, lane, itb);
            tr_job(INP[27], DM_, DM_, 0, DM_, (bf16_t*)(ws + WS_WQ), 0, scr, gw2, NGW2, lane, itb);
            tr_job(INP[29], DM_, DM_, 0, DM_, (bf16_t*)(ws + WS_WO), 0, scr, gw2, NGW2, lane, itb);
        }
    }
    SEAM(7);
    if (IN(8)) { PH_IDS
        groupnorm_rows((bf16_t*)(ws + WS_Z), INP[20], T_, gw, NGW, lane);
        if (G < 256) { int itb = 0;
        tr_job(INP[8], DM_, 10272, 8224, 2048, (bf16_t*)(ws + WS_WG), 0, scr, gw, NGW, lane, itb);
        tr_job(INP[21], DM_, DM_, 0, DM_, (bf16_t*)(ws + WS_WBA), 0, scr, gw, NGW, lane, itb);
        tr_job(INP[22], 2048, DM_, 0, DM_, (bf16_t*)(ws + WS_WBS), 0, scr, gw, NGW, lane, itb);
        tr_job(INP[23], DM_, DM_, 0, DM_, (bf16_t*)(ws + WS_WMO), 0, scr, gw, NGW, lane, itb);
        tr_job(INP[27], DM_, DM_, 0, DM_, (bf16_t*)(ws + WS_WQ), 0, scr, gw, NGW, lane, itb);
        tr_job(INP[29], DM_, DM_, 0, DM_, (bf16_t*)(ws + WS_WO), 0, scr, gw, NGW, lane, itb); }
    }
    SEAM(8);
    if (IN(9)) { PH_IDS
        { Gemm g{ABUF, (const bf16_t*)(ws + WS_WG), T_, 2048, DM_}; PairOrder S; S.base.init(T_, DM_, G, bx); EpiB<0> E{(bf16_t*)(ws + WS_GA), 1024, nullptr, 1024, (WS_GS - WS_GA) / 2};
          gemm_phase<EpiB<0>, PairOrder, true, true>(lds, g, S, E); }
        { Gemm g{(const bf16_t*)(ws + WS_Q), (const bf16_t*)(ws + WS_WBA), T_, DM_, DM_}; StaticOrder S; S.init(T_, DM_, G, bx); EpiBranch<false> E{(const bf16_t*)(ws + WS_GA), nullptr, (bf16_t*)(ws + WS_TMP), INP[9]};
          gemm_phase<EpiBranch<false>, StaticOrder, true, true>(lds, g, S, E); }
        { Gemm g{(const bf16_t*)(ws + WS_Z), (const bf16_t*)(ws + WS_WBS), T_, DM_, 2048}; StaticOrder S; S.init(T_, DM_, G, bx); EpiBranch<true> E{(const bf16_t*)(ws + WS_GS), (const bf16_t*)(ws + WS_TMP), (bf16_t*)(ws + WS_GA), INP[9] + 1024};
          gemm_phase<EpiBranch<true>, StaticOrder, true, true>(lds, g, S, E); }
    }
    SEAM(9);
    if (IN(10)) { PH_IDS
        Gemm g{(const bf16_t*)(ws + WS_GA), (const bf16_t*)(ws + WS_WMO), T_, DM_, DM_}; StaticOrder S; S.init(T_, DM_, G, bx); EpiB<0> E{(bf16_t*)(ws + WS_YBUF_B), DM_, nullptr, 0, 0};
        gemm_phase<EpiB<0>, StaticOrder, true, true>(lds, g, S, E);
    }
    SEAM(10);
    if (IN(11)) { PH_IDS
        rowwise<true, true>((const bf16_t*)(ws + WS_YBUF_B), RB, INP[7], 1.0f, RB, INP[24], ABUF, T_, gw, NGW, lane);
        int itb = 0;
        tr_job(INP[32], DM_, 2 * DFF_, 0, 2 * DFF_, (bf16_t*)(ws + WS_WGU), 1, scr, gw, NGW, lane, itb);
        tr_job(INP[33], DFF_, DM_, 0, DM_, (bf16_t*)(ws + WS_WD), 0, scr, gw, NGW, lane, itb);
    }
    SEAM(11);
    if (IN(12)) { PH_IDS
        Gemm g{ABUF, (const bf16_t*)(ws + WS_WQ), T_, DM_, DM_}; StaticOrder S; S.init(T_, DM_, G, bx); EpiB<0> E{(bf16_t*)(ws + WS_QX), 1024, nullptr, 0, 0};
        gemm_phase<EpiB<0>, StaticOrder, true, true>(lds, g, S, E);
        asm volatile("s_waitcnt vmcnt(0) lgkmcnt(0)" ::: "memory"); __syncthreads();
        Unit u;
        for (int i = 0; S.next(i, u); ++i)
            for (int dh = 0; dh < 2; ++dh)
                xattn_unit(u.pm >> 4, u.pn, u.pm & 15, dh, (const bf16_t*)(ws + WS_QX), (const bf16_t*)(ws + WS_KX), (const bf16_t*)(ws + WS_VXT), (bf16_t*)(ws + WS_XO), lds, wid, lane);
    }
    SEAM(13);
    if (IN(14)) { PH_IDS
        Gemm g{(const bf16_t*)(ws + WS_XO), (const bf16_t*)(ws + WS_WO), T_, DM_, DM_}; StaticOrder S; S.init(T_, DM_, G, bx); EpiB<0> E{(bf16_t*)(ws + WS_YBUF_B), DM_, nullptr, 0, 0};
        gemm_phase<EpiB<0>, StaticOrder, true, true>(lds, g, S, E);
    }
    SEAM(14);
    if (IN(15)) { PH_IDS rowwise<true, true>((const bf16_t*)(ws + WS_YBUF_B), RB, INP[25], 1.0f, RB, INP[30], ABUF, T_, gw, NGW, lane); }
    SEAM(15);
    if (IN(16)) { PH_IDS
        Gemm g{ABUF, (const bf16_t*)(ws + WS_WGU), T_, 2 * DFF_, DM_}; StaticOrder S; S.init(T_, 2 * DFF_, G, bx); EpiSwiglu E{(bf16_t*)(ws + WS_HBUF), DFF_};
        gemm_phase<EpiSwiglu, StaticOrder, true, true>(lds, g, S, E);
    }
    SEAM(16);
    if (IN(17)) { PH_IDS
        Gemm g{(const bf16_t*)(ws + WS_HBUF), (const bf16_t*)(ws + WS_WD), T_, DM_, DFF_}; StaticOrder S; S.init(T_, DM_, G, bx); EpiB<0> E{(bf16_t*)(ws + WS_YBUF_A), DM_, nullptr, 0, 0};
        gemm_phase<EpiB<0>, StaticOrder, true, true>(lds, g, S, E);
    }
    SEAM(17);
    if (IN(18)) { PH_IDS
        f32x4 res[8][4];
#pragma unroll
        for (int i = 0; i < 8; ++i) { const size_t m = (size_t)gw * 8 + i; load_row<true>(res[i], RB, m, lane); add_normed(res[i], (const bf16_t*)(ws + WS_YBUF_A), m, INP[31], 0.5f, lane); }
        GSYNC_W(32, 3);
#pragma unroll
        for (int i = 0; i < 8; ++i) { f32x4* o = (f32x4*)(out + ((size_t)gw * 8 + i) * DM_) + lane;
#pragma unroll
            for (int j = 0; j < 4; ++j) o[64 * j] = res[i][j]; }
    }
#undef IN
#undef SEAM
}

#ifndef MK_PER_PHASE
#define MK_PER_PHASE 0
#endif
extern "C" void kernel_launch(void* const* d_in, const int* in_sizes, int n_in, void* d_out, int out_size, void* d_ws, size_t ws_size, hipStream_t stream) {
    static int grid = 0;
    if (grid == 0) {
        if (n_in != 34 || out_size != T_ * DM_ || ws_size < WS_NEED) { fprintf(stderr, "kernel_launch: unexpected shapes (n_in %d, out %d, ws %zu); nothing launched\n", n_in, out_size, ws_size); grid = -1; return; }
        int dev = 0, cus = 0, per_cu = 0;
        if (hipGetDevice(&dev) != hipSuccess || hipDeviceGetAttribute(&cus, hipDeviceAttributeMultiprocessorCount, dev) != hipSuccess) { grid = -1; return; }
        if (hipFuncSetAttribute((const void*)mk_fwd, hipFuncAttributeMaxDynamicSharedMemorySize, LDS_BYTES) != hipSuccess) { fprintf(stderr, "kernel_launch: hipFuncSetAttribute failed\n"); grid = -1; return; }
        if (hipOccupancyMaxActiveBlocksPerMultiprocessor(&per_cu, (const void*)mk_fwd, NTHREADS, LDS_BYTES) != hipSuccess || per_cu < 1) { fprintf(stderr, "kernel_launch: occupancy query says %d blocks per CU\n", per_cu); (void)hipGetLastError(); grid = -1; return; }
        if (cus != 256) { fprintf(stderr, "kernel_launch: built for a 256-CU device (the final phase deals 8 rows to each of 2048 waves); found %d CUs, nothing launched\n", cus); grid = -1; return; }
        grid = cus;
    }
    if (grid < 0) return;
    (void)hipMemsetAsync((char*)d_ws + 8192, 0, 16384, stream);
    Args a{};
    for (int i = 0; i < 34; ++i) a.in[i] = (const float*)d_in[i];
    a.out = (float*)d_out; a.ws = (unsigned char*)d_ws;
#if MK_PER_PHASE
    for (int p = 0; p < N_PHASES; ++p) {
        a.ph_lo = p; a.ph_hi = p + 1;
        void* args[] = {&a};
        hipError_t e = hipLaunchCooperativeKernel((const void*)mk_fwd, dim3(grid), dim3(NTHREADS), args, LDS_BYTES, stream);
        if (e != hipSuccess) { fprintf(stderr, "launch %d failed: %s\n", p, hipGetErrorString(e)); break; }
    }
#else
    a.ph_lo = 0; a.ph_hi = N_PHASES;
    void* args[] = {&a};
    hipError_t e = hipLaunchCooperativeKernel((const void*)mk_fwd, dim3(grid), dim3(NTHREADS), args, LDS_BYTES, stream);
    if (e != hipSuccess) fprintf(stderr, "cooperative launch failed: %s (grid %d)\n", hipGetErrorString(e), grid);
#endif
}
```

```cpp
#include <hip/hip_runtime.h>
#include <hip/hip_cooperative_groups.h>
#include <cstdio>
#include <cstdint>
namespace cg = cooperative_groups;
namespace pg8 {
#define PG8_LAS __attribute__((address_space(3)))
typedef unsigned short bf16_t;
typedef short bf16x8 __attribute__((ext_vector_type(8)));
typedef float f32x4 __attribute__((ext_vector_type(4)));
typedef unsigned u32x4 __attribute__((ext_vector_type(4)));
constexpr int BM = 256, BK = 64, HALF = 128, HTB = HALF * BK * 2  , STAGE_BYTES = 8 * HTB, NXCD = 8, WGM = 8;

__host__ __device__ __forceinline__ int lds_byte(int r, int c) { const int st = (r >> 4) * 2 + (c >> 5), rr = r & 15, cc = c & 31, ob = rr * 64 + cc * 2; return st * 1024 + (ob ^ (((ob >> 9) & 1) << 5)); }
__host__ __device__ __forceinline__ void stage_rc(int b, int& R, int& C) { const int st = b / 1024, sb = b % 1024, swz = sb ^ (((sb >> 9) & 1) << 5); R = (st >> 1) * 16 + swz / 64; C = (st & 1) * 32 + (swz % 64) / 2; }
__host__ __device__ __forceinline__ int perm32(int rho) { const int n = rho >> 4, i = rho & 15; return 8 * (i >> 2) + 4 * n + (i & 3); }

struct Unit { int pm, pn; };
struct Gemm { const bf16_t* A; const bf16_t* Bt; int M, N, K; };

struct StaticOrder {
    int nM, nN, nwg, G, c;
    __host__ __device__ void init(int M, int N, int G_, int c_) { nM = M / BM; nN = N / BM; nwg = nM * nN; G = G_; c = c_; }
    __host__ __device__ __forceinline__ bool next(int i, Unit& u) const {
        const long L = (long)i * G + c; if (L >= nwg) return false;
        int wgid = (int)L; { const int q = nwg / NXCD, r = nwg % NXCD, xcd = wgid % NXCD, off = wgid / NXCD; wgid = (xcd < r ? xcd * (q + 1) : r * (q + 1) + (xcd - r) * q) + off; }
        const int nig = WGM * nN, gid = wgid / nig, fm = gid * WGM, gsz = (nM - fm) < WGM ? (nM - fm) : WGM;
        u.pm = fm + ((wgid % nig) % gsz); u.pn = (wgid % nig) / gsz; return true;
    }
    __device__ __forceinline__ void a_ready(const Unit&) const {}
    __device__ __forceinline__ void done(const Unit&) const {}
};

__device__ __forceinline__ unsigned cvt_pk_bf16(float lo, float hi) { unsigned r; asm volatile("v_cvt_pk_bf16_f32 %0, %1, %2" : "=v"(r) : "v"(lo), "v"(hi)); return r; }
typedef float f32x2 __attribute__((ext_vector_type(2)));
typedef unsigned u32x2 __attribute__((ext_vector_type(2)));
__device__ __forceinline__ float fsigmoid(float x) { return __builtin_amdgcn_rcpf(1.0f + __builtin_amdgcn_exp2f(-1.4426950408889634f * x)); }
__device__ __forceinline__ float fsilu(float x) { return x * fsigmoid(x); }
__device__ __forceinline__ float bf_lo(unsigned w) { return __uint_as_float(w << 16); }
__device__ __forceinline__ float bf_hi(unsigned w) { return __uint_as_float(w & 0xffff0000u); }
__device__ __forceinline__ u32x4 pack8(f32x4 v0, f32x4 v1) { u32x4 w; w.x = cvt_pk_bf16(v0[0], v0[1]); w.y = cvt_pk_bf16(v0[2], v0[3]); w.z = cvt_pk_bf16(v1[0], v1[1]); w.w = cvt_pk_bf16(v1[2], v1[3]); return w; }

template <int ACT  > struct EpiB {
    static constexpr bool PERM = true, AFTER_DRAIN = false;
    bf16_t* O; int ldc; const float* bias; int split_cols; size_t split_stride;
    __device__ __forceinline__ void operator()(const f32x4 (&acc)[2][2][4][2], const Unit& u, int wr, int wc, int fr, int fq) const {
        const int row0 = u.pm * BM + wr * 64 + fr; int colt = u.pn * BM; bf16_t* base = O;
        if (split_cols) { const int t = colt / split_cols; base += (size_t)t * split_stride; colt -= t * split_cols; }
        const int col0 = colt + wc * 32 + 8 * fq, bcol0 = u.pn * BM + wc * 32 + 8 * fq;
        f32x4 bv[2][2];
#pragma unroll
        for (int bj = 0; bj < 2; ++bj)
#pragma unroll
            for (int n = 0; n < 2; ++n) bv[bj][n] = bias ? *(const f32x4*)(bias + bcol0 + bj * HALF + 4 * n) : (f32x4){0.f, 0.f, 0.f, 0.f};
#pragma unroll
        for (int ai = 0; ai < 2; ++ai)
#pragma unroll
            for (int m = 0; m < 4; ++m) { bf16_t* rowp = base + (size_t)(row0 + ai * HALF + m * 16) * ldc + col0;
#pragma unroll
                for (int bj = 0; bj < 2; ++bj) { f32x4 v0 = acc[ai][bj][m][0] + bv[bj][0], v1 = acc[ai][bj][m][1] + bv[bj][1];
                    if (ACT == 2) {
#pragma unroll
                        for (int j = 0; j < 4; ++j) { v0[j] = fsigmoid(v0[j]); v1[j] = fsigmoid(v1[j]); } }
                    *(u32x4*)(rowp + bj * HALF) = pack8(v0, v1); } }
    }
};
struct EpiSwiglu {
    static constexpr bool PERM = true, AFTER_DRAIN = false;
    bf16_t* O; int ldc;
    __device__ __forceinline__ void operator()(const f32x4 (&acc)[2][2][4][2], const Unit& u, int wr, int wc, int fr, int fq) const {
        const int row0 = u.pm * BM + wr * 64 + fr; const int col0 = u.pn * HALF + wc * 32 + 8 * fq;
#pragma unroll
        for (int ai = 0; ai < 2; ++ai)
#pragma unroll
            for (int m = 0; m < 4; ++m) { bf16_t* rowp = O + (size_t)(row0 + ai * HALF + m * 16) * ldc + col0;
                f32x4 h0, h1;
#pragma unroll
                for (int j = 0; j < 4; ++j) { h0[j] = fsilu(acc[ai][0][m][0][j]) * acc[ai][1][m][0][j]; h1[j] = fsilu(acc[ai][0][m][1][j]) * acc[ai][1][m][1][j]; }
                *(u32x4*)rowp = pack8(h0, h1); }
    }
};
struct EpiF32 {
    static constexpr bool PERM = false, AFTER_DRAIN = false;
    float* O; int ldc;
    __device__ __forceinline__ void operator()(const f32x4 (&acc)[2][2][4][2], const Unit& u, int wr, int wc, int fr, int fq) const {
        const int row0 = u.pm * BM + wr * 64 + fr; const int col0 = u.pn * BM + wc * 32 + 4 * fq;
#pragma unroll
        for (int ai = 0; ai < 2; ++ai)
#pragma unroll
            for (int m = 0; m < 4; ++m) { float* rowp = O + (size_t)(row0 + ai * HALF + m * 16) * ldc + col0;
#pragma unroll
                for (int bj = 0; bj < 2; ++bj)
#pragma unroll
                    for (int n = 0; n < 2; ++n) *(f32x4*)(rowp + bj * HALF + n * 16) = acc[ai][bj][m][n]; }
    }
};
struct EpiInB {
    static constexpr bool PERM = true, AFTER_DRAIN = false;
    bf16_t* Z; bf16_t* XS; bf16_t* BC; float* dtT; const float* dt_bias; int Mrows;
    __device__ __forceinline__ void operator()(const f32x4 (&acc)[2][2][4][2], const Unit& u, int wr, int wc, int fr, int fq) const {
        const int row0 = u.pm * BM + wr * 64 + fr;
        if (u.pn < 20) {
            bf16_t* base; int ldc, colt;
            if (u.pn < 8) { base = Z; ldc = 2048; colt = u.pn * BM; } else if (u.pn < 16) { base = XS; ldc = 2048; colt = (u.pn - 8) * BM; } else { base = BC; ldc = 1024; colt = (u.pn - 16) * BM; }
            const int col0 = colt + wc * 32 + 8 * fq;
#pragma unroll
            for (int ai = 0; ai < 2; ++ai)
#pragma unroll
                for (int m = 0; m < 4; ++m) { bf16_t* rowp = base + (size_t)(row0 + ai * HALF + m * 16) * ldc + col0;
#pragma unroll
                    for (int bj = 0; bj < 2; ++bj) *(u32x4*)(rowp + bj * HALF) = pack8(acc[ai][bj][m][0], acc[ai][bj][m][1]); }
        } else if (wc == 0) {
#pragma unroll
            for (int ai = 0; ai < 2; ++ai)
#pragma unroll
                for (int m = 0; m < 4; ++m) { const int row = row0 + ai * HALF + m * 16;
#pragma unroll
                    for (int n = 0; n < 2; ++n)
#pragma unroll
                        for (int j = 0; j < 4; ++j) { const int c = 8 * fq + 4 * n + j; const float x = acc[ai][0][m][n][j] + dt_bias[c];
                            dtT[(size_t)c * Mrows + row] = x > 20.f ? x : log1pf(__expf(x)); } }
        }
    }
};
template <bool ADD> struct EpiBranch {
    static constexpr bool PERM = true, AFTER_DRAIN = false;
    const bf16_t* G; const bf16_t* Tm; bf16_t* D; const float* gbias;
    __device__ __forceinline__ void operator()(const f32x4 (&acc)[2][2][4][2], const Unit& u, int wr, int wc, int fr, int fq) const {
        const int row0 = u.pm * BM + wr * 64 + fr; const int col0 = u.pn * BM + wc * 32 + 8 * fq;
        float gb[2][8];
#pragma unroll
        for (int bj = 0; bj < 2; ++bj)
#pragma unroll
            for (int j = 0; j < 8; ++j) gb[bj][j] = gbias[col0 + bj * HALF + j];
#pragma unroll
        for (int ai = 0; ai < 2; ++ai) {
            u32x4 gv[4][2], tv[4][2];
#pragma unroll
            for (int m = 0; m < 4; ++m)
#pragma unroll
                for (int bj = 0; bj < 2; ++bj) { const size_t off = (size_t)(row0 + ai * HALF + m * 16) * 1024 + col0 + bj * HALF;
                    gv[m][bj] = *(const u32x4*)(G + off); tv[m][bj] = ADD ? *(const u32x4*)(Tm + off) : (u32x4){0u, 0u, 0u, 0u}; }
#pragma unroll
            for (int m = 0; m < 4; ++m)
#pragma unroll
                for (int bj = 0; bj < 2; ++bj) { const size_t off = (size_t)(row0 + ai * HALF + m * 16) * 1024 + col0 + bj * HALF;
                    const u32x4 g4 = gv[m][bj], t4 = tv[m][bj];
                    f32x4 v0 = acc[ai][bj][m][0], v1 = acc[ai][bj][m][1];
                    v0[0] = fsigmoid(bf_lo(g4.x) + gb[bj][0]) * v0[0] + bf_lo(t4.x); v0[1] = fsigmoid(bf_hi(g4.x) + gb[bj][1]) * v0[1] + bf_hi(t4.x);
                    v0[2] = fsigmoid(bf_lo(g4.y) + gb[bj][2]) * v0[2] + bf_lo(t4.y); v0[3] = fsigmoid(bf_hi(g4.y) + gb[bj][3]) * v0[3] + bf_hi(t4.y);
                    v1[0] = fsigmoid(bf_lo(g4.z) + gb[bj][4]) * v1[0] + bf_lo(t4.z); v1[1] = fsigmoid(bf_hi(g4.z) + gb[bj][5]) * v1[1] + bf_hi(t4.z);
                    v1[2] = fsigmoid(bf_lo(g4.w) + gb[bj][6]) * v1[2] + bf_lo(t4.w); v1[3] = fsigmoid(bf_hi(g4.w) + gb[bj][7]) * v1[3] + bf_hi(t4.w);
                    *(u32x4*)(D + off) = pack8(v0, v1); }
        }
    }
};
template <class Epi, class Sched, bool ALIGN_EPI = false, bool SP2 = false>
__device__ __forceinline__ void gemm_phase(PG8_LAS unsigned char* lds, const Gemm g, const Sched& S, const Epi& E) {
    const int tid = threadIdx.x, wid = __builtin_amdgcn_readfirstlane(tid >> 6), lane = tid & 63, wr = wid >> 2, wc = wid & 3, fr = lane & 15, fq = lane >> 4;
    const int K = g.K, nt = K / BK;
    unsigned voffA[2], voffB[2];
#pragma unroll
    for (int i = 0; i < 2; ++i) { int R, C; stage_rc(tid * 16 + i * 8192, R, C); const int Rb = Epi::PERM ? ((R & ~31) + perm32(R & 31)) : R;
        voffA[i] = (unsigned)(R * K + C) * 2u; voffB[i] = (unsigned)(Rb * K + C) * 2u; }
    const size_t kstep = (size_t)(BK * 2);
    const size_t hstep = (size_t)HALF * K * 2;
    const size_t tstep = 2 * hstep;
    const unsigned ldsw = (unsigned)wid * 1024u;
    const int aoff = lds_byte(wr * 64 + fr, fq * 8), boff = lds_byte(wc * 32 + fr, fq * 8);
#define PG8_SA(b, h) (((b) * 2 + (h)) * HTB)
#define PG8_SB(b, h) ((4 + (b) * 2 + (h)) * HTB)
#define PG8_STAGE(bufoff, gbase, voff) do { _Pragma("unroll") for (int _i = 0; _i < 2; ++_i) \
        __builtin_amdgcn_global_load_lds((const unsigned*)((const char*)(gbase) + (voff)[_i]), (PG8_LAS unsigned*)(lds + (bufoff) + ldsw + _i * 8192), 16, 0, 0); } while (0)
#define PG8_LDA(dst, b, h) do { _Pragma("unroll") for (int m = 0; m < 4; ++m) _Pragma("unroll") for (int k = 0; k < 2; ++k) dst[m][k] = *(const PG8_LAS bf16x8*)(lds + PG8_SA(b, h) + aoff + m * 2048 + k * 1024); } while (0)
#define PG8_LDB(dst, b, h) do { _Pragma("unroll") for (int n = 0; n < 2; ++n) _Pragma("unroll") for (int k = 0; k < 2; ++k) dst[n][k] = *(const PG8_LAS bf16x8*)(lds + PG8_SB(b, h) + boff + n * 2048 + k * 1024); } while (0)
#define PG8_MMA(ai, bj, At, Bt) do { __builtin_amdgcn_s_setprio(1); _Pragma("unroll") for (int m = 0; m < 4; ++m) _Pragma("unroll") for (int n = 0; n < 2; ++n) _Pragma("unroll") for (int k = 0; k < 2; ++k) \
        acc[ai][bj][m][n] = __builtin_amdgcn_mfma_f32_16x16x32_bf16(Bt[n][k], At[m][k], acc[ai][bj][m][n], 0, 0, 0); __builtin_amdgcn_s_setprio(0); } while (0)
#define PG8_WAIT_V(n) asm volatile("s_waitcnt vmcnt(" #n ")" ::: "memory")
#define PG8_WAIT_L(n) asm volatile("s_waitcnt lgkmcnt(" #n ")" ::: "memory")
#define PG8_BAR __builtin_amdgcn_s_barrier()
#define PG8_SCHED __builtin_amdgcn_sched_barrier(0)
    Unit cur, nxt; int ui = 0;
    if (!S.next(0, cur)) return;
    f32x4 acc[2][2][4][2];
#pragma unroll
    for (int a = 0; a < 2; ++a)
#pragma unroll
        for (int b = 0; b < 2; ++b)
#pragma unroll
            for (int m = 0; m < 4; ++m)
#pragma unroll
                for (int n = 0; n < 2; ++n) acc[a][b][m][n] = (f32x4){0.f, 0.f, 0.f, 0.f};
    bf16x8 At[4][2], B0[2][2], B1[2][2];
    const char* cA = (const char*)g.A + (size_t)cur.pm * tstep; const char* cB = (const char*)g.Bt + (size_t)cur.pn * tstep;
    S.a_ready(cur);
    if constexpr (SP2) {
        PG8_STAGE(PG8_SB(0, 0), cB, voffB); PG8_STAGE(PG8_SB(0, 1), cB + hstep, voffB); PG8_STAGE(PG8_SA(0, 0), cA, voffA); PG8_STAGE(PG8_SA(0, 1), cA + hstep, voffA);
        if (wr == 1) PG8_BAR;
        PG8_WAIT_V(2); PG8_BAR;
        PG8_STAGE(PG8_SB(1, 0), cB + kstep, voffB); PG8_STAGE(PG8_SA(1, 0), cA + kstep, voffA); PG8_STAGE(PG8_SB(1, 1), cB + hstep + kstep, voffB);
        PG8_WAIT_V(6); PG8_BAR;
    } else {
        PG8_STAGE(PG8_SB(0, 0), cB, voffB); PG8_STAGE(PG8_SA(0, 0), cA, voffA); PG8_STAGE(PG8_SB(0, 1), cB + hstep, voffB); PG8_STAGE(PG8_SA(0, 1), cA + hstep, voffA);
        if (wr == 1) PG8_BAR;
        PG8_WAIT_V(4); PG8_BAR;
        PG8_STAGE(PG8_SB(1, 0), cB + kstep, voffB); PG8_STAGE(PG8_SA(1, 0), cA + kstep, voffA); PG8_STAGE(PG8_SB(1, 1), cB + hstep + kstep, voffB);
        PG8_WAIT_V(6); PG8_BAR;
    }
    for (;;) {
        const bool has_next = S.next(ui + 1, nxt);
        const char* nA = has_next ? (const char*)g.A + (size_t)nxt.pm * tstep : cA; const char* nB = has_next ? (const char*)g.Bt + (size_t)nxt.pn * tstep : cB;
        for (int t = 0; t < nt; t += 2) {
            const bool last = (t == nt - 2);
            const char* a1 = cA + (size_t)(t + 1) * kstep;
            const char* a2 = last ? nA : cA + (size_t)(t + 2) * kstep; const char* b2 = last ? nB : cB + (size_t)(t + 2) * kstep;
            const char* a3 = a2 + kstep; const char* b3 = b2 + kstep;
            if (last && has_next) S.a_ready(nxt);
            if constexpr (SP2) {
            PG8_LDB(B0, 0, 0); PG8_LDB(B1, 0, 1); PG8_SCHED; PG8_LDA(At, 0, 0); PG8_STAGE(PG8_SA(1, 1), a1 + hstep, voffA);
            PG8_WAIT_V(8); PG8_WAIT_L(0); PG8_BAR; PG8_MMA(0, 0, At, B0); PG8_MMA(0, 1, At, B1); PG8_BAR; PG8_SCHED;
            PG8_LDA(At, 0, 1); PG8_STAGE(PG8_SB(0, 0), b2, voffB); PG8_STAGE(PG8_SB(0, 1), b2 + hstep, voffB); PG8_STAGE(PG8_SA(0, 0), a2, voffA);
            PG8_WAIT_V(8); PG8_WAIT_L(0); PG8_BAR; PG8_MMA(1, 0, At, B0); PG8_MMA(1, 1, At, B1); PG8_BAR; PG8_SCHED;
            PG8_LDB(B0, 1, 0); PG8_LDB(B1, 1, 1); PG8_SCHED; PG8_LDA(At, 1, 0); PG8_STAGE(PG8_SA(0, 1), a2 + hstep, voffA);
            PG8_WAIT_V(8); PG8_WAIT_L(0); PG8_BAR; PG8_MMA(0, 0, At, B0); PG8_MMA(0, 1, At, B1); PG8_BAR; PG8_SCHED;
            PG8_LDA(At, 1, 1); PG8_STAGE(PG8_SB(1, 0), b3, voffB); PG8_STAGE(PG8_SB(1, 1), b3 + hstep, voffB); PG8_STAGE(PG8_SA(1, 0), a3, voffA);
            PG8_WAIT_V(8); PG8_WAIT_L(0); PG8_BAR; PG8_MMA(1, 0, At, B0); PG8_MMA(1, 1, At, B1); PG8_BAR; PG8_SCHED;
            } else {
            PG8_LDB(B0, 0, 0); PG8_SCHED; PG8_LDA(At, 0, 0); PG8_STAGE(PG8_SA(1, 1), a1 + hstep, voffA);
            PG8_WAIT_L(8); PG8_BAR; PG8_WAIT_L(0); PG8_MMA(0, 0, At, B0); PG8_BAR; PG8_SCHED;
            PG8_LDB(B1, 0, 1); PG8_STAGE(PG8_SB(0, 0), b2, voffB);
            PG8_BAR; PG8_WAIT_L(0); PG8_MMA(0, 1, At, B1); PG8_BAR;
            PG8_LDA(At, 0, 1); PG8_STAGE(PG8_SA(0, 0), a2, voffA);
            PG8_BAR; PG8_WAIT_L(0); PG8_MMA(1, 0, At, B0); PG8_BAR; PG8_SCHED;
            PG8_STAGE(PG8_SB(0, 1), b2 + hstep, voffB);
            PG8_WAIT_V(6); PG8_BAR; PG8_MMA(1, 1, At, B1); PG8_BAR;
            PG8_LDB(B0, 1, 0); PG8_SCHED; PG8_LDA(At, 1, 0); PG8_STAGE(PG8_SA(0, 1), a2 + hstep, voffA);
            PG8_WAIT_L(8); PG8_BAR; PG8_WAIT_L(0); PG8_MMA(0, 0, At, B0); PG8_BAR; PG8_SCHED;
            PG8_LDB(B1, 1, 1); PG8_STAGE(PG8_SB(1, 0), b3, voffB);
            PG8_BAR; PG8_WAIT_L(0); PG8_MMA(0, 1, At, B1); PG8_BAR;
            PG8_LDA(At, 1, 1); PG8_STAGE(PG8_SA(1, 0), a3, voffA);
            PG8_BAR; PG8_WAIT_L(0); PG8_MMA(1, 0, At, B0); PG8_BAR; PG8_SCHED;
            PG8_STAGE(PG8_SB(1, 1), b3 + hstep, voffB);
            PG8_WAIT_V(6); PG8_BAR; PG8_MMA(1, 1, At, B1); PG8_BAR;
            }
        }
        if constexpr (ALIGN_EPI) { if (wr == 0) PG8_BAR; }
        if constexpr (!Epi::AFTER_DRAIN) { E(acc, cur, wr, wc, fr, fq); S.done(cur); }
        if (!has_next) break;
#pragma unroll
        for (int a = 0; a < 2; ++a)
#pragma unroll
            for (int b = 0; b < 2; ++b)
#pragma unroll
                for (int m = 0; m < 4; ++m)
#pragma unroll
                    for (int n = 0; n < 2; ++n) acc[a][b][m][n] = (f32x4){0.f, 0.f, 0.f, 0.f};
        cur = nxt; cA = nA; cB = nB; ++ui;
        if constexpr (ALIGN_EPI) { if (wr == 1) PG8_BAR; }
    }
    PG8_WAIT_V(0);
    if constexpr (!ALIGN_EPI) { if (wr == 0) PG8_BAR; }
    PG8_BAR;
    if constexpr (Epi::AFTER_DRAIN) { E.fused(acc, cur, wr, wc, fr, fq, lds, wid, lane); S.done(cur); }
#undef PG8_SA
#undef PG8_SB
#undef PG8_STAGE
#undef PG8_LDA
#undef PG8_LDB
#undef PG8_MMA
#undef PG8_WAIT_V
#undef PG8_WAIT_L
#undef PG8_BAR
#undef PG8_SCHED
}
}
#define LAS __attribute__((address_space(3)))
typedef unsigned short bf16_t;
typedef short bf16x8 __attribute__((ext_vector_type(8)));
typedef short s16x4 __attribute__((ext_vector_type(4)));
typedef float f32x4 __attribute__((ext_vector_type(4)));
typedef float f32x16 __attribute__((ext_vector_type(16)));
typedef unsigned u32x4 __attribute__((ext_vector_type(4)));
typedef unsigned u32x2 __attribute__((ext_vector_type(2)));

constexpr int T_ = 16384, SEQ_ = 4096, NB_ = 4, DM_ = 1024, DFF_ = 2816, MEMT_ = 1024;
constexpr int NWAVES = 8, NTHREADS = 512;
constexpr int LDS_BYTES = 155648;
constexpr size_t MiB = 1u << 20;
constexpr size_t WS_KX = 1 * MiB, WS_VXT = 3 * MiB, WS_DTT = 5 * MiB, WS_WIN = 7 * MiB, WS_ABUF = 24 * MiB, WS_Q = 56 * MiB, WS_K = 88 * MiB, WS_VT = 120 * MiB;
constexpr size_t WS_Z = 88 * MiB, WS_XS = 152 * MiB, WS_BC = 216 * MiB;
constexpr size_t WS_HBUF = 56 * MiB, WS_YBUF_A = 152 * MiB, WS_YBUF_B = 88 * MiB;
constexpr size_t WS_WGU = 216 * MiB, WS_WD = 227 * MiB, WS_WKV = 233 * MiB, WS_MEMN = 237 * MiB;
constexpr size_t WS_WG = 7 * MiB, WS_WBA = 11 * MiB, WS_WBS = 13 * MiB, WS_WMO = 17 * MiB, WS_WQ = 19 * MiB, WS_WO = 21 * MiB;
constexpr size_t WS_GA = 152 * MiB, WS_GS = 184 * MiB, WS_TMP = 216 * MiB, WS_QX = 56 * MiB, WS_XO = 152 * MiB;
constexpr size_t WS_NEED = 248 * MiB;

__device__ __forceinline__ float wave_sum(float v) {
#pragma unroll
    for (int o = 1; o < 64; o <<= 1) v += __shfl_xor(v, o);
    return v;
}
typedef float f32x2_t __attribute__((ext_vector_type(2))); typedef __bf16 bf16x2_t __attribute__((ext_vector_type(2)));
__device__ __forceinline__ unsigned pk2(float lo, float hi) { f32x2_t v = {lo, hi}; bf16x2_t b = __builtin_convertvector(v, bf16x2_t); return __builtin_bit_cast(unsigned, b); }
__device__ __forceinline__ unsigned short bf1(float x) { return (unsigned short)(pk2(x, 0.f) & 0xffffu); }
__device__ __forceinline__ float bflo(unsigned w) { return __uint_as_float(w << 16); }
__device__ __forceinline__ float bfhi(unsigned w) { return __uint_as_float(w & 0xffff0000u); }
__device__ __forceinline__ float bf2f(unsigned short h) { return __uint_as_float(((unsigned)h) << 16); }
__device__ __forceinline__ float fsigm(float x) { return __builtin_amdgcn_rcpf(1.0f + __builtin_amdgcn_exp2f(-1.4426950408889634f * x)); }
__device__ __forceinline__ int crow(int r, int hi) { return (r & 3) + 8 * (r >> 2) + 4 * hi; }
#define MFMA32(a, b, c) __builtin_amdgcn_mfma_f32_32x32x16_bf16((a), (b), (c), 0, 0, 0)

__device__ __forceinline__ void tr_job(const float* W, int K, int N, int ncol0, int ncols, bf16_t* WT, int mode, LAS float* scr, int gw, int NGW, int lane, int& itbase) {
    const int nblk = ncols / 32, nitems = (K / 64) * nblk;
    int first = (gw - (itbase % NGW) + NGW) % NGW;
    for (int it = first; it < nitems; it += NGW) {
        const int kb = it / nblk, nb = it % nblk, k0 = 64 * kb, n0 = ncol0 + 32 * nb;
        int drow0;
        if (mode == 0) drow0 = n0 - ncol0;
        else { const int c = n0 < DFF_ ? n0 : n0 - DFF_; drow0 = 256 * (c / 128) + (c % 128) + (n0 < DFF_ ? 0 : 128); }
#pragma unroll
        for (int i = 0; i < 8; ++i) { const int kk = 8 * i + (lane >> 3), n4 = 4 * (lane & 7); const f32x4 v = __builtin_nontemporal_load((const f32x4*)(W + (size_t)(k0 + kk) * N + n0 + n4));
            scr[kk * 33 + n4] = v.x; scr[kk * 33 + n4 + 1] = v.y; scr[kk * 33 + n4 + 2] = v.z; scr[kk * 33 + n4 + 3] = v.w; }
        asm volatile("s_waitcnt lgkmcnt(0)" ::: "memory");
        const int c = lane & 7;
#pragma unroll
        for (int j = 0; j < 4; ++j) { const int n = (lane >> 3) + 8 * j; const LAS float* s = scr + (8 * c) * 33 + n;
            u32x4 o; o.x = pk2(s[0 * 33], s[1 * 33]); o.y = pk2(s[2 * 33], s[3 * 33]); o.z = pk2(s[4 * 33], s[5 * 33]); o.w = pk2(s[6 * 33], s[7 * 33]);
            *(u32x4*)(WT + (size_t)(drow0 + n) * K + k0 + 8 * c) = o; }
        asm volatile("s_waitcnt lgkmcnt(0)" ::: "memory");
    }
    itbase += nitems;
}

template <bool BF> __device__ __forceinline__ void load_row(f32x4 (&r)[4], const void* base, size_t m, int lane) {
    if (BF) { const u32x2* p = (const u32x2*)((const bf16_t*)base + m * DM_) + lane;
#pragma unroll
        for (int j = 0; j < 4; ++j) { const u32x2 w = p[64 * j]; r[j] = (f32x4){bflo(w.x), bfhi(w.x), bflo(w.y), bfhi(w.y)}; } }
    else { const f32x4* p = (const f32x4*)((const float*)base + m * DM_) + lane;
#pragma unroll
        for (int j = 0; j < 4; ++j) r[j] = p[64 * j]; }
}
__device__ __forceinline__ void add_normed(f32x4 (&r)[4], const bf16_t* y, size_t m, const float* gpost, float coef, int lane) {
    const u32x2* yr = (const u32x2*)(y + m * DM_) + lane; f32x4 v[4]; float s = 0.f;
#pragma unroll
    for (int j = 0; j < 4; ++j) { const u32x2 w = yr[64 * j]; v[j] = (f32x4){bflo(w.x), bfhi(w.x), bflo(w.y), bfhi(w.y)}; s += (v[j].x * v[j].x + v[j].y * v[j].y) + (v[j].z * v[j].z + v[j].w * v[j].w); }
    const float rs = coef * __builtin_amdgcn_rsqf(wave_sum(s) * (1.f / DM_) + 1e-6f);
#pragma unroll
    for (int j = 0; j < 4; ++j) { const f32x4 g = ((const f32x4*)gpost)[lane + 64 * j]; r[j] = r[j] + v[j] * g * rs; }
}
template <bool RIN_BF, bool ROUT_BF>
__device__ __forceinline__ void rowwise(const bf16_t* y, const void* rin, const float* gpost, float coef, void* rout, const float* gpre, bf16_t* aout, int rows, int gw, int NGW, int lane) {
    const int per = (rows + NGW - 1) / NGW;
    for (int m = gw * per; m < gw * per + per && m < rows; ++m) {
        f32x4 r[4];
        load_row<RIN_BF>(r, rin, (size_t)m, lane);
        if (y) add_normed(r, y, (size_t)m, gpost, coef, lane);
        if (rout) {
            if (ROUT_BF) { u32x2* o = (u32x2*)((bf16_t*)rout + (size_t)m * DM_) + lane;
#pragma unroll
                for (int j = 0; j < 4; ++j) { u32x2 w; w.x = pk2(r[j].x, r[j].y); w.y = pk2(r[j].z, r[j].w); o[64 * j] = w; } }
            else { f32x4* o = (f32x4*)((float*)rout + (size_t)m * DM_) + lane;
#pragma unroll
                for (int j = 0; j < 4; ++j) o[64 * j] = r[j]; }
        }
        if (aout) {
            float s = 0.f;
#pragma unroll
            for (int j = 0; j < 4; ++j) s += (r[j].x * r[j].x + r[j].y * r[j].y) + (r[j].z * r[j].z + r[j].w * r[j].w);
            const float rs = __builtin_amdgcn_rsqf(wave_sum(s) * (1.f / DM_) + 1e-6f);
            u32x2* o = (u32x2*)(aout + (size_t)m * DM_) + lane;
#pragma unroll
            for (int j = 0; j < 4; ++j) { const f32x4 g = ((const f32x4*)gpre)[lane + 64 * j]; const f32x4 v = r[j] * g * rs; u32x2 w; w.x = pk2(v.x, v.y); w.y = pk2(v.z, v.w); o[64 * j] = w; }
        }
    }
}
__device__ __forceinline__ void groupnorm_rows(bf16_t* yb, const float* g, int rows, int gw, int NGW, int lane) {
    const int per = (rows + NGW - 1) / NGW;
    for (int m = gw * per; m < gw * per + per && m < rows; ++m) {
        u32x4 w[4];
#pragma unroll
        for (int j = 0; j < 4; ++j) w[j] = *((const u32x4*)(yb + (size_t)m * 2048 + j * 512) + lane);
#pragma unroll
        for (int j = 0; j < 4; ++j) {
            float v[8] = {bflo(w[j].x), bfhi(w[j].x), bflo(w[j].y), bfhi(w[j].y), bflo(w[j].z), bfhi(w[j].z), bflo(w[j].w), bfhi(w[j].w)};
            float s = 0.f;
#pragma unroll
            for (int k = 0; k < 8; ++k) s += v[k] * v[k];
            const float rs = __builtin_amdgcn_rsqf(wave_sum(s) * (1.f / 512.f) + 1e-5f);
            const f32x4 g0 = *(const f32x4*)(g + j * 512 + lane * 8), g1 = *(const f32x4*)(g + j * 512 + lane * 8 + 4);
            u32x4 o; o.x = pk2(v[0] * rs * g0.x, v[1] * rs * g0.y); o.y = pk2(v[2] * rs * g0.z, v[3] * rs * g0.w); o.z = pk2(v[4] * rs * g1.x, v[5] * rs * g1.y); o.w = pk2(v[6] * rs * g1.z, v[7] * rs * g1.w);
            w[j] = o;
        }
#pragma unroll
        for (int j = 0; j < 4; ++j) *((u32x4*)(yb + (size_t)m * 2048 + j * 512) + lane) = w[j];
    }
}

template <int DQK, bool CAUSAL, bool PREFETCH>
__device__ __forceinline__ void flash_pass(f32x16 (&o)[4], const bf16_t* Qrow, const bf16_t* Kbase, int kpitch, const bf16_t* VTbase, int vpitch, int NT, int qpos0, float cscale, LAS unsigned char* lds, int wid, int lane) {
    constexpr int KP = DQK + 8, ND = DQK / 16, KL = DQK / 64, KC = DQK / 8;
    const int tid = threadIdx.x, r32 = lane & 31, hi = lane >> 5;
    constexpr int KSB = 64 * KP * 2, BUFB = KSB + 18432;
    LAS bf16_t* Ks = (LAS bf16_t*)lds; LAS bf16_t* Vs = (LAS bf16_t*)(lds + KSB); volatile LAS float* wsf = (volatile LAS float*)(lds + 2 * BUFB) + wid * 64;
    constexpr bool QREG = (DQK <= 64);
    bf16x8 qf[QREG ? ND : 1];
    if (QREG) {
#pragma unroll
        for (int d0 = 0; d0 < ND; ++d0) qf[d0] = *(const bf16x8*)(Qrow + d0 * 16 + hi * 8);
    }
#pragma unroll
    for (int eb = 0; eb < 4; ++eb)
#pragma unroll
        for (int r = 0; r < 16; ++r) o[eb][r] = 0.f;
    float mrun = -1e30f, lrun = 0.f;
    u32x4 kst[KL], vst[2];
#pragma unroll
    for (int i = 0; i < KL; ++i) { const int ci = tid + NTHREADS * i, row = ci / KC, cc = ci % KC; kst[i] = *(const u32x4*)(Kbase + (size_t)row * kpitch + cc * 8); }
#pragma unroll
    for (int i = 0; i < 2; ++i) { const int ci = tid + NTHREADS * i, e = ci >> 3, cc = ci & 7; vst[i] = *(const u32x4*)(VTbase + (size_t)e * vpitch + cc * 8); }
#pragma unroll
    for (int i = 0; i < KL; ++i) { const int ci = tid + NTHREADS * i, row = ci / KC, cc = ci % KC; *(LAS u32x4*)(Ks + row * KP + cc * 8) = kst[i]; }
#pragma unroll
    for (int i = 0; i < 2; ++i) { const int ci = tid + NTHREADS * i, e = ci >> 3, cc = ci & 7; { LAS bf16_t* vd = Vs + e * 72 + (cc >> 1) * 16 + (cc & 1) * 4; *(LAS u32x2*)vd = (u32x2){vst[i].x, vst[i].y}; *(LAS u32x2*)(vd + 8) = (u32x2){vst[i].z, vst[i].w}; } }
    __syncthreads();
    for (int t = 0; t < NT; ++t) {
        Ks = (LAS bf16_t*)(lds + (t & 1) * BUFB); Vs = (LAS bf16_t*)(lds + (t & 1) * BUFB + KSB);
        if (PREFETCH && t + 1 < NT) {
#pragma unroll
            for (int i = 0; i < KL; ++i) { const int ci = tid + NTHREADS * i, row = ci / KC, cc = ci % KC; kst[i] = *(const u32x4*)(Kbase + (size_t)(64 * (t + 1) + row) * kpitch + cc * 8); }
#pragma unroll
            for (int i = 0; i < 2; ++i) { const int ci = tid + NTHREADS * i, e = ci >> 3, cc = ci & 7; vst[i] = *(const u32x4*)(VTbase + (size_t)e * vpitch + 64 * (t + 1) + cc * 8); }
        }
        const bool active = !CAUSAL || (64 * t <= qpos0 + 31);
        if (active) {
            f32x16 p0, p1;
#pragma unroll
            for (int r = 0; r < 16; ++r) { p0[r] = 0.f; p1[r] = 0.f; }
            if (QREG) {
#pragma unroll
                for (int d0 = 0; d0 < ND; ++d0) {
                    const bf16x8 k0 = *(const LAS bf16x8*)(Ks + r32 * KP + d0 * 16 + hi * 8);
                    const bf16x8 k1 = *(const LAS bf16x8*)(Ks + (32 + r32) * KP + d0 * 16 + hi * 8);
                    p0 = MFMA32(k0, qf[d0], p0); p1 = MFMA32(k1, qf[d0], p1);
                }
            } else {
#pragma unroll 1
                for (int dc = 0; dc < ND; dc += 8) {
                    bf16x8 q4[8];
#pragma unroll
                    for (int i = 0; i < 8; ++i) q4[i] = *(const bf16x8*)(Qrow + (dc + i) * 16 + hi * 8);
#pragma unroll
                    for (int i = 0; i < 8; ++i) {
                        const bf16x8 k0 = *(const LAS bf16x8*)(Ks + r32 * KP + (dc + i) * 16 + hi * 8);
                        const bf16x8 k1 = *(const LAS bf16x8*)(Ks + (32 + r32) * KP + (dc + i) * 16 + hi * 8);
                        p0 = MFMA32(k0, q4[i], p0); p1 = MFMA32(k1, q4[i], p1);
                    }
                }
            }
            if (CAUSAL && (64 * t + 63 > qpos0)) {
                const int qp = qpos0 + r32;
#pragma unroll
                for (int r = 0; r < 16; ++r) { const int kv = 64 * t + crow(r, hi); if (kv > qp) p0[r] = -1e30f; if (kv + 32 > qp) p1[r] = -1e30f; }
            }
            float mt = fmaxf(p0[0], p1[0]);
#pragma unroll
            for (int r = 1; r < 16; ++r) mt = fmaxf(mt, fmaxf(p0[r], p1[r]));
            mt = fmaxf(mt, __shfl_xor(mt, 32));
            const bool grow = __any(mt > mrun + 8.0f / cscale);
            float alpha = 1.0f;
            if (grow) { const float mn = fmaxf(mrun, mt); alpha = __builtin_amdgcn_exp2f((mrun - mn) * cscale); mrun = mn; }
            const float mnc = -mrun * cscale;
            float rs = 0.f;
#pragma unroll
            for (int r = 0; r < 16; ++r) { p0[r] = __builtin_amdgcn_exp2f(__builtin_fmaf(p0[r], cscale, mnc)); p1[r] = __builtin_amdgcn_exp2f(__builtin_fmaf(p1[r], cscale, mnc)); rs += p0[r] + p1[r]; }
            lrun = lrun * alpha + rs;
            if (grow) {
                if (hi == 0) wsf[r32] = alpha;
                asm volatile("s_waitcnt lgkmcnt(0)" ::: "memory");
#pragma unroll
                for (int r = 0; r < 16; ++r) { const float a = wsf[crow(r, hi)];
#pragma unroll
                    for (int eb = 0; eb < 4; ++eb) o[eb][r] *= a; }
            }
#pragma unroll
            for (int half = 0; half < 2; ++half)
#pragma unroll
                for (int rr = 0; rr < 2; ++rr) {
                    u32x4 pw;
                    if (half == 0) { pw.x = pk2(p0[8 * rr + 0], p0[8 * rr + 1]); pw.y = pk2(p0[8 * rr + 2], p0[8 * rr + 3]); pw.z = pk2(p0[8 * rr + 4], p0[8 * rr + 5]); pw.w = pk2(p0[8 * rr + 6], p0[8 * rr + 7]); }
                    else           { pw.x = pk2(p1[8 * rr + 0], p1[8 * rr + 1]); pw.y = pk2(p1[8 * rr + 2], p1[8 * rr + 3]); pw.z = pk2(p1[8 * rr + 4], p1[8 * rr + 5]); pw.w = pk2(p1[8 * rr + 6], p1[8 * rr + 7]); }
                    const bf16x8 pa = __builtin_bit_cast(bf16x8, pw);
#pragma unroll
                    for (int eb = 0; eb < 4; ++eb) {
                        const bf16x8 vb = *(const LAS bf16x8*)(Vs + (32 * eb + r32) * 72 + 32 * half + 16 * rr + 8 * hi);
                        o[eb] = MFMA32(pa, vb, o[eb]);
                    }
                }
        }
        if (t + 1 < NT) {
            LAS bf16_t* Kn = (LAS bf16_t*)(lds + ((t + 1) & 1) * BUFB); LAS bf16_t* Vn = (LAS bf16_t*)(lds + ((t + 1) & 1) * BUFB + KSB);
            if (!PREFETCH) {
#pragma unroll
                for (int i = 0; i < KL; ++i) { const int ci = tid + NTHREADS * i, row = ci / KC, cc = ci % KC; kst[i] = *(const u32x4*)(Kbase + (size_t)(64 * (t + 1) + row) * kpitch + cc * 8); }
#pragma unroll
                for (int i = 0; i < 2; ++i) { const int ci = tid + NTHREADS * i, e = ci >> 3, cc = ci & 7; vst[i] = *(const u32x4*)(VTbase + (size_t)e * vpitch + 64 * (t + 1) + cc * 8); }
            }
#pragma unroll
            for (int i = 0; i < KL; ++i) { const int ci = tid + NTHREADS * i, row = ci / KC, cc = ci % KC; *(LAS u32x4*)(Kn + row * KP + cc * 8) = kst[i]; }
#pragma unroll
            for (int i = 0; i < 2; ++i) { const int ci = tid + NTHREADS * i, e = ci >> 3, cc = ci & 7; { LAS bf16_t* vd = Vn + e * 72 + (cc >> 1) * 16 + (cc & 1) * 4; *(LAS u32x2*)vd = (u32x2){vst[i].x, vst[i].y}; *(LAS u32x2*)(vd + 8) = (u32x2){vst[i].z, vst[i].w}; } }
        }
        __syncthreads();
    }
    lrun += __shfl_xor(lrun, 32);
    if (hi == 0) wsf[r32] = __builtin_amdgcn_rcpf(lrun);
    asm volatile("s_waitcnt lgkmcnt(0)" ::: "memory");
#pragma unroll
    for (int r = 0; r < 16; ++r) { const float a = wsf[crow(r, hi)];
#pragma unroll
        for (int eb = 0; eb < 4; ++eb) o[eb][r] *= a; }
    asm volatile("s_waitcnt lgkmcnt(0)" ::: "memory");
}

__device__ __forceinline__ void diffattn_unit(int b, int h, int qb, const bf16_t* Q, const bf16_t* Kb, const bf16_t* VT, bf16_t* O, float lam, const float* subg, LAS unsigned char* lds, int wid, int lane) {
    const int r32 = lane & 31, hi = lane >> 5;
    const int q0 = 256 * qb, qpos0 = q0 + 32 * wid;
    const size_t trow = (size_t)b * SEQ_ + qpos0 + r32;
    const int NT = 4 * (qb + 1);
    const float cs = 0.125f * 1.4426950408889634f;
    f32x16 o1[4];
    flash_pass<64, true, true>(o1, Q + trow * 1024 + h * 128, Kb + (size_t)b * SEQ_ * 1024 + h * 128, 1024, VT + (size_t)(h * 128) * T_ + (size_t)b * SEQ_, T_, NT, qpos0, cs, lds, wid, lane);
    volatile LAS unsigned* st = (volatile LAS unsigned*)(lds + 57344) + wid * 2048 + lane;
#pragma unroll
    for (int r = 0; r < 16; ++r) { st[(2 * r) * 64] = pk2(o1[0][r], o1[1][r]); st[(2 * r + 1) * 64] = pk2(o1[2][r], o1[3][r]); }
    flash_pass<64, true, true>(o1, Q + trow * 1024 + h * 128 + 64, Kb + (size_t)b * SEQ_ * 1024 + h * 128 + 64, 1024, VT + (size_t)(h * 128) * T_ + (size_t)b * SEQ_, T_, NT, qpos0, cs, lds, wid, lane);
    float gsub[4];
#pragma unroll
    for (int eb = 0; eb < 4; ++eb) gsub[eb] = subg[32 * eb + r32] * 0.8f;
#pragma unroll
    for (int r = 0; r < 16; ++r) {
        const unsigned w0 = st[(2 * r) * 64], w1 = st[(2 * r + 1) * 64];
        float v[4] = {bflo(w0) - lam * o1[0][r], bfhi(w0) - lam * o1[1][r], bflo(w1) - lam * o1[2][r], bfhi(w1) - lam * o1[3][r]};
        float ss = (v[0] * v[0] + v[1] * v[1]) + (v[2] * v[2] + v[3] * v[3]);
#pragma unroll
        for (int off = 1; off < 32; off <<= 1) ss += __shfl_xor(ss, off);
        const float rs = __builtin_amdgcn_rsqf(ss * (1.f / 128.f) + 1e-5f);
        bf16_t* orow = O + ((size_t)b * SEQ_ + qpos0 + crow(r, hi)) * 1024 + h * 128 + r32;
#pragma unroll
        for (int eb = 0; eb < 4; ++eb) orow[32 * eb] = bf1(v[eb] * rs * gsub[eb]);
    }
}
__device__ __forceinline__ void xattn_unit(int b, int h, int qb, int dh, const bf16_t* QX, const bf16_t* KX, const bf16_t* VXT, bf16_t* XO, LAS unsigned char* lds, int wid, int lane) {
    const int r32 = lane & 31, hi = lane >> 5;
    const int qpos0 = 256 * qb + 32 * wid;
    const size_t trow = (size_t)b * SEQ_ + qpos0 + r32;
    f32x16 o[4];
    flash_pass<256, false, true>(o, QX + trow * 1024 + h * 256, KX + (size_t)b * 256 * 1024 + h * 256, 1024, VXT + (size_t)(h * 256 + dh * 128) * MEMT_ + b * 256, MEMT_, 4, 0, 0.0625f * 1.4426950408889634f, lds, wid, lane);
#pragma unroll
    for (int r = 0; r < 16; ++r) {
        bf16_t* orow = XO + ((size_t)b * SEQ_ + qpos0 + crow(r, hi)) * 1024 + h * 256 + dh * 128 + r32;
#pragma unroll
        for (int eb = 0; eb < 4; ++eb) orow[32 * eb] = bf1(o[eb][r]);
    }
}

constexpr int SP = 136;
constexpr int SOFF_BM = 0, SOFF_BT = 34816, SOFF_CM = 69632, SOFF_XT = 104448, SOFF_SB = 121856, SOFF_F = 139264, SOFF_CW = 141824;
template <int STR>
__device__ __forceinline__ void conv8(const u32x4 (&u)[4], const LAS float* cwb, float (&out)[8]) {
#pragma unroll
    for (int k = 0; k < 8; ++k) {
        float acc = cwb[(k * 5 + 4) * STR];
#pragma unroll
        for (int j = 0; j < 4; ++j) { const unsigned w = (k >> 1) == 0 ? u[j].x : (k >> 1) == 1 ? u[j].y : (k >> 1) == 2 ? u[j].z : u[j].w; const float v = (k & 1) ? bfhi(w) : bflo(w); acc += cwb[(k * 5 + j) * STR] * v; }
        out[k] = acc * fsigm(acc);
    }
}
__device__ __forceinline__ void ssd_unit(int b, int h, const bf16_t* XS, const bf16_t* BC, bf16_t* Z, const float* dtT, const float* conv_w, const float* conv_b, const float* A_log, const float* Dp, LAS unsigned char* lds, int wid, int lane) {
    const int tid = threadIdx.x, r32 = lane & 31, hi = lane >> 5, g = h >> 3;
    LAS bf16_t* Bm = (LAS bf16_t*)(lds + SOFF_BM); LAS bf16_t* BT = (LAS bf16_t*)(lds + SOFF_BT); LAS bf16_t* Cm = (LAS bf16_t*)(lds + SOFF_CM);
    LAS bf16_t* XT = (LAS bf16_t*)(lds + SOFF_XT); LAS bf16_t* Sb = (LAS bf16_t*)(lds + SOFF_SB);
    LAS float* acs = (LAS float*)(lds + SOFF_F); LAS float* dec = acs + 128; LAS float* eacs = acs + 256; LAS float* ddt = acs + 384; LAS float* cw = (LAS float*)(lds + SOFF_CW);
    const float a_h = -__expf(A_log[h]), D_h = Dp[h];
    for (int i = tid; i < 1600; i += NTHREADS) {
        int ci, kj;
        if (i < 320) { kj = i >> 3; ci = (i & 7) * 8 + kj / 5; } else if (i < 960) { const int q = i - 320; kj = q >> 4; ci = 64 + (q & 15) * 8 + kj / 5; } else { const int q = i - 960; kj = q >> 4; ci = 192 + (q & 15) * 8 + kj / 5; }
        const int j = kj % 5; const int ch = ci < 64 ? h * 64 + ci : ci < 192 ? 2048 + g * 128 + (ci - 64) : 2560 + g * 128 + (ci - 192);
        cw[i] = j < 4 ? conv_w[j * 3072 + ch] : conv_b[ch]; }
    for (int i = tid; i < 64 * SP / 2; i += NTHREADS) ((LAS unsigned*)Sb)[i] = 0u;
    f32x16 S;
#pragma unroll
    for (int r = 0; r < 16; ++r) S[r] = 0.f;
    __syncthreads();
    float dn0 = dtT[(size_t)h * T_ + (size_t)b * SEQ_ + 2 * lane], dn1 = dtT[(size_t)h * T_ + (size_t)b * SEQ_ + 2 * lane + 1];
    for (int c = 0; c < 32; ++c) {
        const int s0 = 128 * c; const size_t t0 = (size_t)b * SEQ_ + s0;
        if (wid == 0) {
            const float d0 = dn0, d1 = dn1;
            if (c + 1 < 32) { dn0 = dtT[(size_t)h * T_ + t0 + 128 + 2 * lane]; dn1 = dtT[(size_t)h * T_ + t0 + 128 + 2 * lane + 1]; }
            const float a0 = a_h * d0, a1 = a_h * d1; const float pr = a0 + a1; float inc = pr;
#pragma unroll
            for (int off = 1; off < 64; off <<= 1) { const float n = __shfl_up(inc, off); if (lane >= off) inc += n; }
            const float exc = inc - pr, tot = __shfl(inc, 63);
            const float c0 = exc + a0, c1 = inc;
            acs[2 * lane] = c0; acs[2 * lane + 1] = c1; dec[2 * lane] = __expf(tot - c0); dec[2 * lane + 1] = __expf(tot - c1);
            eacs[2 * lane] = __expf(c0); eacs[2 * lane + 1] = __expf(c1); ddt[2 * lane] = D_h / fmaxf(d0, 1e-30f); ddt[2 * lane + 1] = D_h / fmaxf(d1, 1e-30f);
        }
        {
            u32x4 wb[4], wc_[4];
#pragma unroll
            for (int i = 0; i < 4; ++i) { const int item = tid + NTHREADS * i, l = item >> 4, n8 = item & 15; const bf16_t* p = BC + (t0 + l) * 1024 + g * 128 + n8 * 8; wb[i] = *(const u32x4*)p; wc_[i] = *(const u32x4*)(p + 512); }
#pragma unroll
            for (int i = 0; i < 4; ++i) { const int item = tid + NTHREADS * i, l = item >> 4, n8 = item & 15;
                *(LAS u32x4*)(Bm + l * SP + n8 * 8) = wb[i]; *(LAS u32x4*)(Cm + l * SP + n8 * 8) = wc_[i];
                const unsigned short e[8] = {(unsigned short)(wb[i].x & 0xffffu), (unsigned short)(wb[i].x >> 16), (unsigned short)(wb[i].y & 0xffffu), (unsigned short)(wb[i].y >> 16),
                                             (unsigned short)(wb[i].z & 0xffffu), (unsigned short)(wb[i].z >> 16), (unsigned short)(wb[i].w & 0xffffu), (unsigned short)(wb[i].w >> 16)};
#pragma unroll
                for (int k = 0; k < 8; ++k) BT[(n8 * 8 + k) * SP + (l ^ (n8 << 3))] = e[k]; }
        }
        {
            u32x4 ux[2][4]; float dtl[2];
#pragma unroll
            for (int i = 0; i < 2; ++i) { const int item = tid + NTHREADS * i, l = item >> 3, p8 = item & 7;
                dtl[i] = dtT[(size_t)h * T_ + t0 + l];
#pragma unroll
                for (int j = 0; j < 4; ++j) { const int sp = s0 + l - 3 + j;
                    if (sp >= 0) ux[i][j] = *(const u32x4*)(XS + (t0 + l - 3 + j) * 2048 + h * 64 + p8 * 8); else ux[i][j] = (u32x4){0u, 0u, 0u, 0u}; } }
#pragma unroll
            for (int i = 0; i < 2; ++i) { const int item = tid + NTHREADS * i, l = item >> 3, p8 = item & 7;
                float vx[8]; conv8<8>(ux[i], cw + p8, vx);
#pragma unroll
                for (int k = 0; k < 8; ++k) XT[(p8 * 8 + k) * SP + (l ^ (p8 << 3))] = bf1(vx[k] * dtl[i]); }
        }
        __syncthreads();
        f32x16 cb[2];
#pragma unroll
        for (int q = 0; q < 2; ++q) {
            const int idx = wid + 8 * q;
            if (idx < 10) {
                const int lb = idx < 1 ? 0 : idx < 3 ? 1 : idx < 6 ? 2 : 3; const int sb = idx - (lb * (lb + 1)) / 2;
                f32x16 acc;
#pragma unroll
                for (int r = 0; r < 16; ++r) acc[r] = 0.f;
#pragma unroll
                for (int kk = 0; kk < 8; ++kk) { const bf16x8 af = *(const LAS bf16x8*)(Cm + (32 * lb + r32) * SP + 16 * kk + 8 * hi); const bf16x8 bfm = *(const LAS bf16x8*)(Bm + (32 * sb + r32) * SP + 16 * kk + 8 * hi); acc = MFMA32(af, bfm, acc); }
                const int s = 32 * sb + r32; const float as = acs[s];
#pragma unroll
                for (int r = 0; r < 16; ++r) { const int l = 32 * lb + crow(r, hi); const float e = __expf(fminf(acs[l] - as, 0.f)); acc[r] = l >= s ? acc[r] * e : 0.f; }
                cb[q] = acc;
            }
        }
        __syncthreads();
#pragma unroll
        for (int q = 0; q < 2; ++q) {
            const int idx = wid + 8 * q;
            if (idx < 10) {
                const int lb = idx < 1 ? 0 : idx < 3 ? 1 : idx < 6 ? 2 : 3; const int sb = idx - (lb * (lb + 1)) / 2;
#pragma unroll
                for (int r = 0; r < 16; ++r) Bm[(32 * lb + crow(r, hi)) * SP + 32 * sb + r32] = bf1(cb[q][r]);
            }
        }
        __syncthreads();
        {
            const int lb = wid >> 1, pb = wid & 1;
            f32x16 acc;
#pragma unroll
            for (int r = 0; r < 16; ++r) acc[r] = 0.f;
#pragma unroll
            for (int kk = 0; kk < 8; ++kk) { const bf16x8 af = *(const LAS bf16x8*)(Cm + (32 * lb + r32) * SP + 16 * kk + 8 * hi); const bf16x8 bfm = *(const LAS bf16x8*)(Sb + (32 * pb + r32) * SP + 16 * kk + 8 * hi); acc = MFMA32(af, bfm, acc); }
#pragma unroll
            for (int r = 0; r < 16; ++r) acc[r] *= eacs[32 * lb + crow(r, hi)];
            for (int sb = 0; sb <= lb; ++sb)
#pragma unroll
                for (int k2 = 0; k2 < 2; ++k2) { const bf16x8 af = *(const LAS bf16x8*)(Bm + (32 * lb + r32) * SP + 32 * sb + 16 * k2 + 8 * hi); const bf16x8 bfm = *(const LAS bf16x8*)(XT + (32 * pb + r32) * SP + ((32 * sb + 16 * k2 + 8 * hi) ^ (((32 * pb + r32) >> 3) << 3))); acc = MFMA32(af, bfm, acc); }
#pragma unroll
            for (int rg = 0; rg < 4; ++rg) { const int l = 32 * lb + 8 * rg + 4 * hi; const u32x2 xw = *(const LAS u32x2*)(XT + (32 * pb + r32) * SP + (l ^ (((32 * pb + r32) >> 3) << 3)));
                acc[4 * rg + 0] += ddt[l + 0] * bflo(xw.x); acc[4 * rg + 1] += ddt[l + 1] * bfhi(xw.x); acc[4 * rg + 2] += ddt[l + 2] * bflo(xw.y); acc[4 * rg + 3] += ddt[l + 3] * bfhi(xw.y); }
            unsigned short zr[16];
#pragma unroll
            for (int r = 0; r < 16; ++r) zr[r] = Z[(t0 + 32 * lb + crow(r, hi)) * 2048 + h * 64 + 32 * pb + r32];
#pragma unroll
            for (int r = 0; r < 16; ++r) { const float zv = bf2f(zr[r]); Z[(t0 + 32 * lb + crow(r, hi)) * 2048 + h * 64 + 32 * pb + r32] = bf1(acc[r] * zv * fsigm(zv)); }
        }
        {
            const int pb = wid >> 2, nb = wid & 3; const float etot = eacs[127];
#pragma unroll
            for (int r = 0; r < 16; ++r) S[r] *= etot;
#pragma unroll 2
            for (int kk = 0; kk < 8; ++kk) {
                const u32x4 xw = *(const LAS u32x4*)(XT + (32 * pb + r32) * SP + ((16 * kk + 8 * hi) ^ (((32 * pb + r32) >> 3) << 3))); const LAS float* dp = dec + 16 * kk + 8 * hi;
                u32x4 aw; aw.x = pk2(bflo(xw.x) * dp[0], bfhi(xw.x) * dp[1]); aw.y = pk2(bflo(xw.y) * dp[2], bfhi(xw.y) * dp[3]); aw.z = pk2(bflo(xw.z) * dp[4], bfhi(xw.z) * dp[5]); aw.w = pk2(bflo(xw.w) * dp[6], bfhi(xw.w) * dp[7]);
                const bf16x8 bfm = *(const LAS bf16x8*)(BT + (32 * nb + r32) * SP + ((16 * kk + 8 * hi) ^ (((32 * nb + r32) >> 3) << 3)));
                S = MFMA32(__builtin_bit_cast(bf16x8, aw), bfm, S);
            }
            __syncthreads();
#pragma unroll
            for (int r = 0; r < 16; ++r) Sb[(32 * pb + crow(r, hi)) * SP + 32 * nb + r32] = bf1(S[r]);
        }
    }
    __syncthreads();
}

struct PairOrder {
    pg8::StaticOrder base;
    __device__ __forceinline__ bool next(int i, pg8::Unit& u) const { if (!base.next(i >> 1, u)) return false; u.pn += 4 * (i & 1); return true; }
    __device__ __forceinline__ void a_ready(const pg8::Unit&) const {}
    __device__ __forceinline__ void done(const pg8::Unit&) const {}
};
#define XB_USE 1
typedef unsigned v4u_unused_t;
#define XB_TMO      128
#define XB_XCNT(j)  (256  + 64 * (j))
#define XB_XSUB(j)  (1280 + 64 * (j))
#define XB_XGEN(j)  (2304 + 64 * (j))
#define XB_TOP      3328
#define XB_TOPGEN   3392
#define XCD_BAR_WORDS 3456
#define XB_SPIN_CAP (1u << 18)

__device__ __forceinline__ unsigned xb_ld(unsigned* p)              { return __hip_atomic_load(p, __ATOMIC_RELAXED, __HIP_MEMORY_SCOPE_AGENT); }
__device__ __forceinline__ unsigned xb_add(unsigned* p, unsigned v) { return __hip_atomic_fetch_add(p, v, __ATOMIC_RELAXED, __HIP_MEMORY_SCOPE_AGENT); }
__device__ __forceinline__ unsigned xb_xcc_id() { return (unsigned)__builtin_amdgcn_s_getreg((3 << 11) | 20) & 0xFu; }
#define XB_SPIN(cond, bar) do { unsigned _sp = 0; while (cond) { __builtin_amdgcn_s_sleep(1); \
    if ((++_sp & 255u) == 0u) { if (xb_ld(&(bar)[XB_TMO])) break; if (_sp > XB_SPIN_CAP) { atomicAdd(&(bar)[XB_TMO], 1u); break; } } } } while (0)

struct XcdBarrier {
    unsigned* bar; unsigned x;
    volatile LAS unsigned* st;
};

__device__ __forceinline__ XcdBarrier xcd_barrier_post(unsigned* bar, volatile LAS unsigned* st) {
    XcdBarrier b; b.bar = bar; b.x = xb_xcc_id(); b.st = st;
    if (threadIdx.x == 0) (void)xb_add(&bar[XB_XCNT(b.x)], 1u);
    return b;
}
__device__ __forceinline__ void xcd_barrier_complete(unsigned* bar, unsigned x, unsigned& nloc, unsigned& nx) {
    const unsigned G = gridDim.x * gridDim.y * gridDim.z;
    unsigned sum, cnt, mine, sp = 0u;
    for (;;) {
        sum = 0u; cnt = 0u; mine = 0u;
#pragma unroll
        for (unsigned j = 0; j < 16; ++j) { const unsigned c = xb_ld(&bar[XB_XCNT(j)]); sum += c; cnt += (c > 0u) ? 1u : 0u; mine = (j == x) ? c : mine; }
        if (sum == G) break;
        __builtin_amdgcn_s_sleep(1);
        if ((++sp & 255u) == 0u) { if (xb_ld(&bar[XB_TMO])) break; if (sp > XB_SPIN_CAP) { atomicAdd(&bar[XB_TMO], 1u); break; } }
    }
    nloc = mine > 0u ? mine : 1u; nx = cnt > 0u ? cnt : 1u;
}

__device__ __forceinline__ void xcd_barrier(const XcdBarrier& b) {
    asm volatile("s_waitcnt vmcnt(0)" ::: "memory");
    __syncthreads();
    if (threadIdx.x == 0) {
        unsigned* bar = b.bar;
        __builtin_amdgcn_s_waitcnt(0);
        unsigned nloc = b.st[0], nx = b.st[1];
        if (nloc == 0u) { xcd_barrier_complete(bar, b.x, nloc, nx); b.st[0] = nloc; b.st[1] = nx; }
        const unsigned old = xb_add(&bar[XB_XSUB(b.x)], 1u);
        const unsigned gen = old / nloc;
        if (old + 1u == (gen + 1u) * nloc) {
            __builtin_amdgcn_fence(__ATOMIC_RELEASE, "agent");
            asm volatile("s_waitcnt vmcnt(0)" ::: "memory");
            const unsigned og = xb_add(&bar[XB_TOP], 1u);
            const unsigned tg = og / nx;
            if (og + 1u == (tg + 1u) * nx) xb_add(&bar[XB_TOPGEN], 1u);
            else XB_SPIN(xb_ld(&bar[XB_TOPGEN]) == tg, bar);
            __builtin_amdgcn_fence(__ATOMIC_ACQUIRE, "agent");
            xb_add(&bar[XB_XGEN(b.x)], 1u);
            asm volatile("s_waitcnt vmcnt(0)" ::: "memory");
        } else {
            XB_SPIN(xb_ld(&bar[XB_XGEN(b.x)]) == gen, bar);
            __builtin_amdgcn_fence(__ATOMIC_ACQUIRE, "agent");
            asm volatile("s_waitcnt vmcnt(0)" ::: "memory");
        }
    }
    __syncthreads();
}

struct Args { const float* in[34]; float* out; unsigned char* ws; int ph_lo, ph_hi; };
constexpr int N_PHASES = 19;

__global__ void __launch_bounds__(NTHREADS, 2) mk_fwd(Args a) {
    extern __shared__ __attribute__((aligned(16))) unsigned char lds_raw[];
    LAS unsigned char* lds = (LAS unsigned char*)lds_raw;
    cg::grid_group grid = cg::this_grid();
    { volatile LAS unsigned* xst = (volatile LAS unsigned*)(lds + 155632);
      if (threadIdx.x == 0) { xst[0] = 0u; xst[1] = 0u; }
      __syncthreads();
      (void)xcd_barrier_post((unsigned*)(a.ws + 8192), xst); }
    grid.sync();
    const int G = gridDim.x, bx = blockIdx.x;
#define PH_IDS int tid; asm volatile("v_mov_b32 %0, %1" : "=v"(tid) : "v"(threadIdx.x)); const int lane = tid & 63, wid = __builtin_amdgcn_readfirstlane(tid >> 6); \
    const int vcu = (G % 8 == 0) ? (bx % 8) * (G / 8) + bx / 8 : bx; const int gw = vcu * NWAVES + wid, NGW = G * NWAVES; (void)lane; (void)gw; (void)NGW; \
    LAS float* scr = (LAS float*)(lds + wid * 16384); (void)scr; \
    const float* const* INP; { const void* kp_ = (const void*)__builtin_amdgcn_kernarg_segment_ptr(); asm volatile("" : "=s"(INP) : "0"(kp_)); } (void)INP;
    unsigned char* ws = a.ws;
    float* out = a.out; bf16_t* RB = (bf16_t*)a.out + (size_t)T_ * DM_;
    bf16_t* ABUF = (bf16_t*)(ws + WS_ABUF);
#define IN(k) (a.ph_lo <= (k) && (k) < a.ph_hi)
#define GSYNC_W(woff_, target_) do { XcdBarrier xb_; xb_.bar = (unsigned*)(a.ws + 8192); xb_.x = xb_xcc_id(); xb_.st = (volatile LAS unsigned*)(lds + 155632); \
    asm volatile("s_waitcnt vmcnt(0) lgkmcnt(0)" ::: "memory"); xcd_barrier(xb_); } while (0)
#define GSYNC(k) GSYNC_W(0, (k) + 1 - a.ph_lo - (((k) > 12 && a.ph_lo <= 12) ? 1 : 0))
#define SEAM(k) do { if (a.ph_lo <= (k) && (k) + 1 < a.ph_hi) GSYNC(k); } while (0)
    using namespace pg8;

    if (IN(0)) { PH_IDS
        int itb = 0;
        tr_job(INP[4], DM_, 2 * DFF_, 0, 2 * DFF_, (bf16_t*)(ws + WS_WGU), 1, scr, gw, NGW, lane, itb);
        if (G < 256) tr_job(INP[5], DFF_, DM_, 0, DM_, (bf16_t*)(ws + WS_WD), 0, scr, gw, NGW, lane, itb);
        tr_job(INP[8], DM_, 10272, 0, 8224, (bf16_t*)(ws + WS_WIN), 0, scr, gw, NGW, lane, itb);
        tr_job(INP[28], DM_, 2048, 0, 2048, (bf16_t*)(ws + WS_WKV), 0, scr, gw, NGW, lane, itb);
        rowwise<false, false>(nullptr, INP[0], nullptr, 0.f, nullptr, INP[2], ABUF, T_, gw, NGW, lane);
        rowwise<false, false>(nullptr, INP[1], nullptr, 0.f, nullptr, INP[26], (bf16_t*)(ws + WS_MEMN), MEMT_, gw, NGW, lane);
    }
    SEAM(0);
    if (IN(1)) { PH_IDS
        { Gemm g{ABUF, (const bf16_t*)(ws + WS_WGU), T_, 2 * DFF_, DM_}; StaticOrder S; S.init(T_, 2 * DFF_, G, bx); EpiSwiglu E{(bf16_t*)(ws + WS_HBUF), DFF_};
          gemm_phase<EpiSwiglu, StaticOrder, true, true>(lds, g, S, E); }
        { Gemm g{(const bf16_t*)(ws + WS_MEMN), (const bf16_t*)(ws + WS_WKV), MEMT_, 1024, DM_}; StaticOrder S; S.init(MEMT_, 1024, G, (bx + 112) % G); EpiB<0> E{(bf16_t*)(ws + WS_KX), 1024, nullptr, 0, 0};
          gemm_phase<EpiB<0>, StaticOrder, false, true>(lds, g, S, E); }
        { Gemm g{(const bf16_t*)(ws + WS_WKV) + (size_t)1024 * 1024, (const bf16_t*)(ws + WS_MEMN), 1024, MEMT_, DM_}; StaticOrder S; S.init(1024, MEMT_, G, (bx + 128) % G); EpiB<0> E{(bf16_t*)(ws + WS_VXT), MEMT_, nullptr, 0, 0};
          gemm_phase<EpiB<0>, StaticOrder, false, true>(lds, g, S, E); }
            if (G >= 256 && bx >= 128) {
            int tid2; asm volatile("v_mov_b32 %0, %1" : "=v"(tid2) : "v"(threadIdx.x)); const int lane2 = tid2 & 63, wid2 = __builtin_amdgcn_readfirstlane(tid2 >> 6);
            int itb2 = 0; tr_job(INP[5], DFF_, DM_, 0, DM_, (bf16_t*)(ws + WS_WD), 0, (LAS float*)(lds + wid2 * 16384), (bx - 128) * NWAVES + wid2, (G - 128) * NWAVES, lane2, itb2);
        }
    }
    SEAM(1);
    if (IN(2)) { PH_IDS
        Gemm g{(const bf16_t*)(ws + WS_HBUF), (const bf16_t*)(ws + WS_WD), T_, DM_, DFF_}; StaticOrder S; S.init(T_, DM_, G, bx); EpiB<0> E{(bf16_t*)(ws + WS_YBUF_A), DM_, nullptr, 0, 0};
        gemm_phase<EpiB<0>, StaticOrder, false, true>(lds, g, S, E);
    }
    SEAM(2);
    if (IN(3)) { PH_IDS rowwise<false, true>((const bf16_t*)(ws + WS_YBUF_A), INP[0], INP[3], 0.5f, RB, INP[6], ABUF, T_, gw, NGW, lane); }
    SEAM(3);
    if (IN(4)) { PH_IDS
        { Gemm g{ABUF, (const bf16_t*)(ws + WS_WIN), T_, 2048, DM_}; StaticOrder S; S.init(T_, 2048, G, bx); EpiB<0> E{(bf16_t*)(ws + WS_Q), 1024, nullptr, 1024, (WS_K - WS_Q) / 2};
          gemm_phase<EpiB<0>, StaticOrder, true, true>(lds, g, S, E); }
        { Gemm g{(const bf16_t*)(ws + WS_WIN) + (size_t)2048 * 1024, ABUF, 1024, T_, DM_}; StaticOrder S; S.init(1024, T_, G, bx); EpiB<0> E{(bf16_t*)(ws + WS_VT), T_, nullptr, 0, 0};
          gemm_phase<EpiB<0>, StaticOrder, false, true>(lds, g, S, E); }
    }
    SEAM(4);
    if (IN(5)) { PH_IDS
        const float v1 = INP[10][lane] * INP[11][lane], v2 = INP[12][lane] * INP[13][lane];
        const float lam = __expf(wave_sum(v1)) - __expf(wave_sum(v2)) + 0.2f;
        for (int u = vcu; u < 512; u += G) {
            const int v = u & 255, bh = v >> 3, qb = u < 256 ? (v & 7) : 15 - (v & 7);
            diffattn_unit(bh >> 3, bh & 7, qb, (const bf16_t*)(ws + WS_Q), (const bf16_t*)(ws + WS_K), (const bf16_t*)(ws + WS_VT), (bf16_t*)(ws + WS_Q), lam, INP[14], lds, wid, lane);
        }
    }
    SEAM(5);
    if (IN(6)) { PH_IDS
        Gemm g{ABUF, (const bf16_t*)(ws + WS_WIN) + (size_t)3072 * 1024, T_, 5120, DM_}; StaticOrder S; S.init(T_, 5120, G, bx);
        EpiInB E{(bf16_t*)(ws + WS_Z), (bf16_t*)(ws + WS_XS), (bf16_t*)(ws + WS_BC), (float*)(ws + WS_DTT), INP[17], T_};
        gemm_phase<EpiInB, StaticOrder, true, true>(lds, g, S, E);
        if (gw < T_ / 32) {
            const int r32 = lane & 31, hi = lane >> 5; const size_t row0 = (size_t)gw * 32;
            const bf16_t* ap = ABUF + (row0 + r32) * DM_ + 8 * hi; const bf16_t* bp = (const bf16_t*)(ws + WS_WIN) + (size_t)(8192 + r32) * 1024 + 8 * hi;
            f32x16 acc;
#pragma unroll
            for (int r = 0; r < 16; ++r) acc[r] = 0.f;
#pragma unroll 8
            for (int kk = 0; kk < 64; ++kk) acc = MFMA32(*(const bf16x8*)(ap + 16 * kk), *(const bf16x8*)(bp + 16 * kk), acc);
            const float bias = INP[17][r32]; float* dtT = (float*)(ws + WS_DTT);
#pragma unroll
            for (int r = 0; r < 16; ++r) { const float xv = acc[r] + bias; dtT[(size_t)r32 * T_ + row0 + crow(r, hi)] = xv > 20.f ? xv : log1pf(__expf(xv)); }
        }
        GSYNC_W(32, 1);
        { const int gt = gw * 64 + lane, cg = gt & 127, run = gt >> 7; bf16_t* base = (bf16_t*)(ws + WS_BC) + (size_t)run * 16 * 1024 + cg * 8;
          u32x4 rw[19];
#pragma unroll
          for (int j = 0; j < 3; ++j) rw[j] = ((run * 16) % SEQ_ == 0) ? (u32x4){0u, 0u, 0u, 0u} : *(const u32x4*)(base - (size_t)(3 - j) * 1024);
          GSYNC_W(32, 2);
#pragma unroll
          for (int j = 0; j < 16; ++j) rw[3 + j] = *(const u32x4*)(base + (size_t)j * 1024);
          float wv[8][5];
#pragma unroll
          for (int k = 0; k < 8; ++k) {
#pragma unroll
              for (int j = 0; j < 4; ++j) wv[k][j] = INP[15][j * 3072 + 2048 + cg * 8 + k];
              wv[k][4] = INP[16][2048 + cg * 8 + k]; }
#pragma unroll
          for (int i = 0; i < 16; ++i) { float o[8];
#pragma unroll
              for (int k = 0; k < 8; ++k) { float acc = wv[k][4];
#pragma unroll
                  for (int j = 0; j < 4; ++j) { const u32x4 r4 = rw[i + j]; const unsigned w = (k >> 1) == 0 ? r4.x : (k >> 1) == 1 ? r4.y : (k >> 1) == 2 ? r4.z : r4.w; acc += wv[k][j] * ((k & 1) ? bfhi(w) : bflo(w)); }
                  o[k] = acc * fsigm(acc); }
              u32x4 ov; ov.x = pk2(o[0], o[1]); ov.y = pk2(o[2], o[3]); ov.z = pk2(o[4], o[5]); ov.w = pk2(o[6], o[7]);
              *(u32x4*)(base + (size_t)i * 1024) = ov; }
        }
    }
    SEAM(6);
    if (IN(7)) { PH_IDS
        const int ssd_u = (G >= 256) ? (((vcu & 31) < 16) ? (vcu >> 5) * 16 + (vcu & 31) : 128) : vcu;
        for (int u = ssd_u; u < 128; u += G)
            ssd_unit(u >> 5, u & 31, (const bf16_t*)(ws + WS_XS), (const bf16_t*)(ws + WS_BC), (bf16_t*)(ws + WS_Z), (const float*)(ws + WS_DTT), INP[15], INP[16], INP[18], INP[19], lds, wid, lane);
            if (G >= 256 && (vcu & 31) >= 16) {
            int tid2; asm volatile("v_mov_b32 %0, %1" : "=v"(tid2) : "v"(threadIdx.x)); const int lane = tid2 & 63;
            const int gw2 = ((vcu >> 5) * 16 + (vcu & 31) - 16) * NWAVES + wid, NGW2 = (G - 128) * NWAVES; int itb = 0;
            tr_job(INP[8], DM_, 10272, 8224, 2048, (bf16_t*)(ws + WS_WG), 0, scr, gw2, NGW2, lane, itb);
            tr_job(INP[21], DM_, DM_, 0, DM_, (bf16_t*)(ws + WS_WBA), 0, scr, gw2, NGW2, lane, itb);
            tr_job(INP[22], 2048, DM_, 0, DM_, (bf16_t*)(ws + WS_WBS), 0, scr, gw2, NGW2, lane, itb);
            tr_job(INP[23], DM_, DM_, 0, DM_, (bf16_t*)(ws + WS_WMO), 0, scr, gw2, NGW2, lane, itb);
            tr_job(INP[27], DM_, DM_, 0, DM_, (bf16_t*)(ws + WS_WQ), 0, scr, gw2, NGW2, lane, itb);
            tr_job(INP[29], DM_, DM_, 0, DM_, (bf16_t*)(ws + WS_WO), 0, scr, gw2, NGW2, lane, itb);
        }
    }
    SEAM(7);
    if (IN(8)) { PH_IDS
        groupnorm_rows((bf16_t*)(ws + WS_Z), INP[20], T_, gw, NGW, lane);
        if (G < 256) { int itb = 0;
        tr_job(INP[8], DM_, 10272, 8224, 2048, (bf16_t*)(ws + WS_WG), 0, scr, gw, NGW, lane, itb);
        tr_job(INP[21], DM_, DM_, 0, DM_, (bf16_t*)(ws + WS_WBA), 0, scr, gw, NGW, lane, itb);
        tr_job(INP[22], 2048, DM_, 0, DM_, (bf16_t*)(ws + WS_WBS), 0, scr, gw, NGW, lane, itb);
        tr_job(INP[23], DM_, DM_, 0, DM_, (bf16_t*)(ws + WS_WMO), 0, scr, gw, NGW, lane, itb);
        tr_job(INP[27], DM_, DM_, 0, DM_, (bf16_t*)(ws + WS_WQ), 0, scr, gw, NGW, lane, itb);
        tr_job(INP[29], DM_, DM_, 0, DM_, (bf16_t*)(ws + WS_WO), 0, scr, gw, NGW, lane, itb); }
    }
    SEAM(8);
    if (IN(9)) { PH_IDS
        { Gemm g{ABUF, (const bf16_t*)(ws + WS_WG), T_, 2048, DM_}; PairOrder S; S.base.init(T_, DM_, G, bx); EpiB<0> E{(bf16_t*)(ws + WS_GA), 1024, nullptr, 1024, (WS_GS - WS_GA) / 2};
          gemm_phase<EpiB<0>, PairOrder, true, true>(lds, g, S, E); }
        { Gemm g{(const bf16_t*)(ws + WS_Q), (const bf16_t*)(ws + WS_WBA), T_, DM_, DM_}; StaticOrder S; S.init(T_, DM_, G, bx); EpiBranch<false> E{(const bf16_t*)(ws + WS_GA), nullptr, (bf16_t*)(ws + WS_TMP), INP[9]};
          gemm_phase<EpiBranch<false>, StaticOrder, false, true>(lds, g, S, E); }
        { Gemm g{(const bf16_t*)(ws + WS_Z), (const bf16_t*)(ws + WS_WBS), T_, DM_, 2048}; StaticOrder S; S.init(T_, DM_, G, bx); EpiBranch<true> E{(const bf16_t*)(ws + WS_GS), (const bf16_t*)(ws + WS_TMP), (bf16_t*)(ws + WS_GA), INP[9] + 1024};
          gemm_phase<EpiBranch<true>, StaticOrder, false, true>(lds, g, S, E); }
    }
    SEAM(9);
    if (IN(10)) { PH_IDS
        Gemm g{(const bf16_t*)(ws + WS_GA), (const bf16_t*)(ws + WS_WMO), T_, DM_, DM_}; StaticOrder S; S.init(T_, DM_, G, bx); EpiB<0> E{(bf16_t*)(ws + WS_YBUF_B), DM_, nullptr, 0, 0};
        gemm_phase<EpiB<0>, StaticOrder, false, true>(lds, g, S, E);
    }
    SEAM(10);
    if (IN(11)) { PH_IDS
        rowwise<true, true>((const bf16_t*)(ws + WS_YBUF_B), RB, INP[7], 1.0f, RB, INP[24], ABUF, T_, gw, NGW, lane);
        int itb = 0;
        tr_job(INP[32], DM_, 2 * DFF_, 0, 2 * DFF_, (bf16_t*)(ws + WS_WGU), 1, scr, gw, NGW, lane, itb);
        if (G < 256) tr_job(INP[33], DFF_, DM_, 0, DM_, (bf16_t*)(ws + WS_WD), 0, scr, gw, NGW, lane, itb);
    }
    SEAM(11);
    if (IN(12)) { PH_IDS
        Gemm g{ABUF, (const bf16_t*)(ws + WS_WQ), T_, DM_, DM_}; StaticOrder S; S.init(T_, DM_, G, bx); EpiB<0> E{(bf16_t*)(ws + WS_QX), 1024, nullptr, 0, 0};
        gemm_phase<EpiB<0>, StaticOrder, false, true>(lds, g, S, E);
        asm volatile("s_waitcnt vmcnt(0) lgkmcnt(0)" ::: "memory"); __syncthreads();
        Unit u;
        for (int i = 0; S.next(i, u); ++i)
            for (int dh = 0; dh < 2; ++dh)
                xattn_unit(u.pm >> 4, u.pn, u.pm & 15, dh, (const bf16_t*)(ws + WS_QX), (const bf16_t*)(ws + WS_KX), (const bf16_t*)(ws + WS_VXT), (bf16_t*)(ws + WS_XO), lds, wid, lane);
    }
    SEAM(13);
    if (IN(14)) { PH_IDS
        Gemm g{(const bf16_t*)(ws + WS_XO), (const bf16_t*)(ws + WS_WO), T_, DM_, DM_}; StaticOrder S; S.init(T_, DM_, G, bx); EpiB<0> E{(bf16_t*)(ws + WS_YBUF_B), DM_, nullptr, 0, 0};
        gemm_phase<EpiB<0>, StaticOrder, false, true>(lds, g, S, E);
    }
    SEAM(14);
    if (IN(15)) { PH_IDS rowwise<true, true>((const bf16_t*)(ws + WS_YBUF_B), RB, INP[25], 1.0f, RB, INP[30], ABUF, T_, gw, NGW, lane); }
    SEAM(15);
    if (IN(16)) { PH_IDS
        Gemm g{ABUF, (const bf16_t*)(ws + WS_WGU), T_, 2 * DFF_, DM_}; StaticOrder S; S.init(T_, 2 * DFF_, G, bx); EpiSwiglu E{(bf16_t*)(ws + WS_HBUF), DFF_};
        gemm_phase<EpiSwiglu, StaticOrder, true, true>(lds, g, S, E);
            if (G >= 256 && bx >= 128) {
            int tid2; asm volatile("v_mov_b32 %0, %1" : "=v"(tid2) : "v"(threadIdx.x)); const int lane2 = tid2 & 63, wid2 = __builtin_amdgcn_readfirstlane(tid2 >> 6);
            int itb2 = 0; tr_job(INP[33], DFF_, DM_, 0, DM_, (bf16_t*)(ws + WS_WD), 0, (LAS float*)(lds + wid2 * 16384), (bx - 128) * NWAVES + wid2, (G - 128) * NWAVES, lane2, itb2);
        }
    }
    SEAM(16);
    if (IN(17)) { PH_IDS
        Gemm g{(const bf16_t*)(ws + WS_HBUF), (const bf16_t*)(ws + WS_WD), T_, DM_, DFF_}; StaticOrder S; S.init(T_, DM_, G, bx); EpiB<0> E{(bf16_t*)(ws + WS_YBUF_A), DM_, nullptr, 0, 0};
        gemm_phase<EpiB<0>, StaticOrder, false, true>(lds, g, S, E);
    }
    SEAM(17);
    if (IN(18)) { PH_IDS
        f32x4 res[8][4];
#pragma unroll
        for (int i = 0; i < 8; ++i) { const size_t m = (size_t)gw * 8 + i; load_row<true>(res[i], RB, m, lane); add_normed(res[i], (const bf16_t*)(ws + WS_YBUF_A), m, INP[31], 0.5f, lane); }
        GSYNC_W(32, 3);
#pragma unroll
        for (int i = 0; i < 8; ++i) { f32x4* o = (f32x4*)(out + ((size_t)gw * 8 + i) * DM_) + lane;
#pragma unroll
            for (int j = 0; j < 4; ++j) o[64 * j] = res[i][j]; }
    }
#undef IN
#undef SEAM
}

#ifndef MK_PER_PHASE
#define MK_PER_PHASE 0
#endif
extern "C" void kernel_launch(void* const* d_in, const int* in_sizes, int n_in, void* d_out, int out_size, void* d_ws, size_t ws_size, hipStream_t stream) {
    static int grid = 0;
    if (grid == 0) {
        if (n_in != 34 || out_size != T_ * DM_ || ws_size < WS_NEED) { fprintf(stderr, "kernel_launch: unexpected shapes (n_in %d, out %d, ws %zu); nothing launched\n", n_in, out_size, ws_size); grid = -1; return; }
        int dev = 0, cus = 0, per_cu = 0;
        if (hipGetDevice(&dev) != hipSuccess || hipDeviceGetAttribute(&cus, hipDeviceAttributeMultiprocessorCount, dev) != hipSuccess) { grid = -1; return; }
        if (hipFuncSetAttribute((const void*)mk_fwd, hipFuncAttributeMaxDynamicSharedMemorySize, LDS_BYTES) != hipSuccess) { fprintf(stderr, "kernel_launch: hipFuncSetAttribute failed\n"); grid = -1; return; }
        if (hipOccupancyMaxActiveBlocksPerMultiprocessor(&per_cu, (const void*)mk_fwd, NTHREADS, LDS_BYTES) != hipSuccess || per_cu < 1) { fprintf(stderr, "kernel_launch: occupancy query says %d blocks per CU\n", per_cu); (void)hipGetLastError(); grid = -1; return; }
        if (cus != 256) { fprintf(stderr, "kernel_launch: built for a 256-CU device (the final phase deals 8 rows to each of 2048 waves); found %d CUs, nothing launched\n", cus); grid = -1; return; }
        grid = cus;
    }
    if (grid < 0) return;
    (void)hipMemsetAsync((char*)d_ws + 8192, 0, 16384, stream);
    Args a{};
    for (int i = 0; i < 34; ++i) a.in[i] = (const float*)d_in[i];
    a.out = (float*)d_out; a.ws = (unsigned char*)d_ws;
#if MK_PER_PHASE
    for (int p = 0; p < N_PHASES; ++p) {
        a.ph_lo = p; a.ph_hi = p + 1;
        void* args[] = {&a};
        hipError_t e = hipLaunchCooperativeKernel((const void*)mk_fwd, dim3(grid), dim3(NTHREADS), args, LDS_BYTES, stream);
        if (e != hipSuccess) { fprintf(stderr, "launch %d failed: %s\n", p, hipGetErrorString(e)); break; }
    }
#else
    a.ph_lo = 0; a.ph_hi = N_PHASES;
    void* args[] = {&a};
    hipError_t e = hipLaunchCooperativeKernel((const void*)mk_fwd, dim3(grid), dim3(NTHREADS), args, LDS_BYTES, stream);
    if (e != hipSuccess) fprintf(stderr, "cooperative launch failed: %s (grid %d)\n", hipGetErrorString(e), grid);
#endif
}
```

```cpp
#include <hip/hip_runtime.h>
#include <hip/hip_cooperative_groups.h>
#include <cstdio>
#include <cstdint>
namespace cg = cooperative_groups;
namespace pg8 {
#define PG8_LAS __attribute__((address_space(3)))
typedef unsigned short bf16_t;
typedef short bf16x8 __attribute__((ext_vector_type(8)));
typedef float f32x4 __attribute__((ext_vector_type(4)));
typedef unsigned u32x4 __attribute__((ext_vector_type(4)));
constexpr int BM = 256, BK = 64, HALF = 128, HTB = HALF * BK * 2  , STAGE_BYTES = 8 * HTB, NXCD = 8, WGM = 8;

__host__ __device__ __forceinline__ int lds_byte(int r, int c) { const int st = (r >> 4) * 2 + (c >> 5), rr = r & 15, cc = c & 31, ob = rr * 64 + cc * 2; return st * 1024 + (ob ^ (((ob >> 9) & 1) << 5)); }
__host__ __device__ __forceinline__ void stage_rc(int b, int& R, int& C) { const int st = b / 1024, sb = b % 1024, swz = sb ^ (((sb >> 9) & 1) << 5); R = (st >> 1) * 16 + swz / 64; C = (st & 1) * 32 + (swz % 64) / 2; }
__host__ __device__ __forceinline__ int perm32(int rho) { const int n = rho >> 4, i = rho & 15; return 8 * (i >> 2) + 4 * n + (i & 3); }

struct Unit { int pm, pn; };
struct Gemm { const bf16_t* A; const bf16_t* Bt; int M, N, K; };

struct StaticOrder {
    int nM, nN, nwg, G, c;
    __host__ __device__ void init(int M, int N, int G_, int c_) { nM = M / BM; nN = N / BM; nwg = nM * nN; G = G_; c = c_; }
    __host__ __device__ __forceinline__ bool next(int i, Unit& u) const {
        const long L = (long)i * G + c; if (L >= nwg) return false;
        int wgid = (int)L; { const int q = nwg / NXCD, r = nwg % NXCD, xcd = wgid % NXCD, off = wgid / NXCD; wgid = (xcd < r ? xcd * (q + 1) : r * (q + 1) + (xcd - r) * q) + off; }
        const int nig = WGM * nN, gid = wgid / nig, fm = gid * WGM, gsz = (nM - fm) < WGM ? (nM - fm) : WGM;
        u.pm = fm + ((wgid % nig) % gsz); u.pn = (wgid % nig) / gsz; return true;
    }
    __device__ __forceinline__ void a_ready(const Unit&) const {}
    __device__ __forceinline__ void done(const Unit&) const {}
};

__device__ __forceinline__ unsigned cvt_pk_bf16(float lo, float hi) { unsigned r; asm volatile("v_cvt_pk_bf16_f32 %0, %1, %2" : "=v"(r) : "v"(lo), "v"(hi)); return r; }
typedef float f32x2 __attribute__((ext_vector_type(2)));
typedef unsigned u32x2 __attribute__((ext_vector_type(2)));
__device__ __forceinline__ float fsigmoid(float x) { return __builtin_amdgcn_rcpf(1.0f + __builtin_amdgcn_exp2f(-1.4426950408889634f * x)); }
__device__ __forceinline__ float fsilu(float x) { return x * fsigmoid(x); }
__device__ __forceinline__ float bf_lo(unsigned w) { return __uint_as_float(w << 16); }
__device__ __forceinline__ float bf_hi(unsigned w) { return __uint_as_float(w & 0xffff0000u); }
__device__ __forceinline__ u32x4 pack8(f32x4 v0, f32x4 v1) { u32x4 w; w.x = cvt_pk_bf16(v0[0], v0[1]); w.y = cvt_pk_bf16(v0[2], v0[3]); w.z = cvt_pk_bf16(v1[0], v1[1]); w.w = cvt_pk_bf16(v1[2], v1[3]); return w; }

template <int ACT  > struct EpiB {
    static constexpr bool PERM = true, AFTER_DRAIN = false;
    bf16_t* O; int ldc; const float* bias; int split_cols; size_t split_stride;
    __device__ __forceinline__ void operator()(const f32x4 (&acc)[2][2][4][2], const Unit& u, int wr, int wc, int fr, int fq) const {
        const int row0 = u.pm * BM + wr * 64 + fr; int colt = u.pn * BM; bf16_t* base = O;
        if (split_cols) { const int t = colt / split_cols; base += (size_t)t * split_stride; colt -= t * split_cols; }
        const int col0 = colt + wc * 32 + 8 * fq, bcol0 = u.pn * BM + wc * 32 + 8 * fq;
        f32x4 bv[2][2];
#pragma unroll
        for (int bj = 0; bj < 2; ++bj)
#pragma unroll
            for (int n = 0; n < 2; ++n) bv[bj][n] = bias ? *(const f32x4*)(bias + bcol0 + bj * HALF + 4 * n) : (f32x4){0.f, 0.f, 0.f, 0.f};
#pragma unroll
        for (int ai = 0; ai < 2; ++ai)
#pragma unroll
            for (int m = 0; m < 4; ++m) { bf16_t* rowp = base + (size_t)(row0 + ai * HALF + m * 16) * ldc + col0;
#pragma unroll
                for (int bj = 0; bj < 2; ++bj) { f32x4 v0 = acc[ai][bj][m][0] + bv[bj][0], v1 = acc[ai][bj][m][1] + bv[bj][1];
                    if (ACT == 2) {
#pragma unroll
                        for (int j = 0; j < 4; ++j) { v0[j] = fsigmoid(v0[j]); v1[j] = fsigmoid(v1[j]); } }
                    *(u32x4*)(rowp + bj * HALF) = pack8(v0, v1); } }
    }
};
struct EpiSwiglu {
    static constexpr bool PERM = true, AFTER_DRAIN = false;
    bf16_t* O; int ldc;
    __device__ __forceinline__ void operator()(const f32x4 (&acc)[2][2][4][2], const Unit& u, int wr, int wc, int fr, int fq) const {
        const int row0 = u.pm * BM + wr * 64 + fr; const int col0 = u.pn * HALF + wc * 32 + 8 * fq;
#pragma unroll
        for (int ai = 0; ai < 2; ++ai)
#pragma unroll
            for (int m = 0; m < 4; ++m) { bf16_t* rowp = O + (size_t)(row0 + ai * HALF + m * 16) * ldc + col0;
                f32x4 h0, h1;
#pragma unroll
                for (int j = 0; j < 4; ++j) { h0[j] = fsilu(acc[ai][0][m][0][j]) * acc[ai][1][m][0][j]; h1[j] = fsilu(acc[ai][0][m][1][j]) * acc[ai][1][m][1][j]; }
                *(u32x4*)rowp = pack8(h0, h1); }
    }
};
struct EpiF32 {
    static constexpr bool PERM = false, AFTER_DRAIN = false;
    float* O; int ldc;
    __device__ __forceinline__ void operator()(const f32x4 (&acc)[2][2][4][2], const Unit& u, int wr, int wc, int fr, int fq) const {
        const int row0 = u.pm * BM + wr * 64 + fr; const int col0 = u.pn * BM + wc * 32 + 4 * fq;
#pragma unroll
        for (int ai = 0; ai < 2; ++ai)
#pragma unroll
            for (int m = 0; m < 4; ++m) { float* rowp = O + (size_t)(row0 + ai * HALF + m * 16) * ldc + col0;
#pragma unroll
                for (int bj = 0; bj < 2; ++bj)
#pragma unroll
                    for (int n = 0; n < 2; ++n) *(f32x4*)(rowp + bj * HALF + n * 16) = acc[ai][bj][m][n]; }
    }
};
struct EpiInB {
    static constexpr bool PERM = true, AFTER_DRAIN = false;
    bf16_t* Z; bf16_t* XS; bf16_t* BC; float* dtT; const float* dt_bias; int Mrows;
    __device__ __forceinline__ void operator()(const f32x4 (&acc)[2][2][4][2], const Unit& u, int wr, int wc, int fr, int fq) const {
        const int row0 = u.pm * BM + wr * 64 + fr;
        if (u.pn < 20) {
            bf16_t* base; int ldc, colt;
            if (u.pn < 8) { base = Z; ldc = 2048; colt = u.pn * BM; } else if (u.pn < 16) { base = XS; ldc = 2048; colt = (u.pn - 8) * BM; } else { base = BC; ldc = 1024; colt = (u.pn - 16) * BM; }
            const int col0 = colt + wc * 32 + 8 * fq;
#pragma unroll
            for (int ai = 0; ai < 2; ++ai)
#pragma unroll
                for (int m = 0; m < 4; ++m) { bf16_t* rowp = base + (size_t)(row0 + ai * HALF + m * 16) * ldc + col0;
#pragma unroll
                    for (int bj = 0; bj < 2; ++bj) *(u32x4*)(rowp + bj * HALF) = pack8(acc[ai][bj][m][0], acc[ai][bj][m][1]); }
        } else if (wc == 0) {
#pragma unroll
            for (int ai = 0; ai < 2; ++ai)
#pragma unroll
                for (int m = 0; m < 4; ++m) { const int row = row0 + ai * HALF + m * 16;
#pragma unroll
                    for (int n = 0; n < 2; ++n)
#pragma unroll
                        for (int j = 0; j < 4; ++j) { const int c = 8 * fq + 4 * n + j; const float x = acc[ai][0][m][n][j] + dt_bias[c];
                            dtT[(size_t)c * Mrows + row] = x > 20.f ? x : log1pf(__expf(x)); } }
        }
    }
};
template <bool ADD> struct EpiBranch {
    static constexpr bool PERM = true, AFTER_DRAIN = false;
    const bf16_t* G; const bf16_t* Tm; bf16_t* D; const float* gbias;
    __device__ __forceinline__ void operator()(const f32x4 (&acc)[2][2][4][2], const Unit& u, int wr, int wc, int fr, int fq) const {
        const int row0 = u.pm * BM + wr * 64 + fr; const int col0 = u.pn * BM + wc * 32 + 8 * fq;
        float gb[2][8];
#pragma unroll
        for (int bj = 0; bj < 2; ++bj)
#pragma unroll
            for (int j = 0; j < 8; ++j) gb[bj][j] = gbias[col0 + bj * HALF + j];
#pragma unroll
        for (int ai = 0; ai < 2; ++ai) {
            u32x4 gv[4][2], tv[4][2];
#pragma unroll
            for (int m = 0; m < 4; ++m)
#pragma unroll
                for (int bj = 0; bj < 2; ++bj) { const size_t off = (size_t)(row0 + ai * HALF + m * 16) * 1024 + col0 + bj * HALF;
                    gv[m][bj] = *(const u32x4*)(G + off); tv[m][bj] = ADD ? *(const u32x4*)(Tm + off) : (u32x4){0u, 0u, 0u, 0u}; }
#pragma unroll
            for (int m = 0; m < 4; ++m)
#pragma unroll
                for (int bj = 0; bj < 2; ++bj) { const size_t off = (size_t)(row0 + ai * HALF + m * 16) * 1024 + col0 + bj * HALF;
                    const u32x4 g4 = gv[m][bj], t4 = tv[m][bj];
                    f32x4 v0 = acc[ai][bj][m][0], v1 = acc[ai][bj][m][1];
                    v0[0] = fsigmoid(bf_lo(g4.x) + gb[bj][0]) * v0[0] + bf_lo(t4.x); v0[1] = fsigmoid(bf_hi(g4.x) + gb[bj][1]) * v0[1] + bf_hi(t4.x);
                    v0[2] = fsigmoid(bf_lo(g4.y) + gb[bj][2]) * v0[2] + bf_lo(t4.y); v0[3] = fsigmoid(bf_hi(g4.y) + gb[bj][3]) * v0[3] + bf_hi(t4.y);
                    v1[0] = fsigmoid(bf_lo(g4.z) + gb[bj][4]) * v1[0] + bf_lo(t4.z); v1[1] = fsigmoid(bf_hi(g4.z) + gb[bj][5]) * v1[1] + bf_hi(t4.z);
                    v1[2] = fsigmoid(bf_lo(g4.w) + gb[bj][6]) * v1[2] + bf_lo(t4.w); v1[3] = fsigmoid(bf_hi(g4.w) + gb[bj][7]) * v1[3] + bf_hi(t4.w);
                    *(u32x4*)(D + off) = pack8(v0, v1); }
        }
    }
};
template <class Epi, class Sched, bool ALIGN_EPI = false, bool SP2 = false>
__device__ __forceinline__ void gemm_phase(PG8_LAS unsigned char* lds, const Gemm g, const Sched& S, const Epi& E) {
    const int tid = threadIdx.x, wid = __builtin_amdgcn_readfirstlane(tid >> 6), lane = tid & 63, wr = wid >> 2, wc = wid & 3, fr = lane & 15, fq = lane >> 4;
    const int K = g.K, nt = K / BK;
    unsigned voffA[2], voffB[2];
#pragma unroll
    for (int i = 0; i < 2; ++i) { int R, C; stage_rc(tid * 16 + i * 8192, R, C); const int Rb = Epi::PERM ? ((R & ~31) + perm32(R & 31)) : R;
        voffA[i] = (unsigned)(R * K + C) * 2u; voffB[i] = (unsigned)(Rb * K + C) * 2u; }
    const size_t kstep = (size_t)(BK * 2);
    const size_t hstep = (size_t)HALF * K * 2;
    const size_t tstep = 2 * hstep;
    const unsigned ldsw = (unsigned)wid * 1024u;
    const int aoff = lds_byte(wr * 64 + fr, fq * 8), boff = lds_byte(wc * 32 + fr, fq * 8);
#define PG8_SA(b, h) (((b) * 2 + (h)) * HTB)
#define PG8_SB(b, h) ((4 + (b) * 2 + (h)) * HTB)
#define PG8_STAGE(bufoff, gbase, voff) do { _Pragma("unroll") for (int _i = 0; _i < 2; ++_i) \
        __builtin_amdgcn_global_load_lds((const unsigned*)((const char*)(gbase) + (voff)[_i]), (PG8_LAS unsigned*)(lds + (bufoff) + ldsw + _i * 8192), 16, 0, 0); } while (0)
#define PG8_LDA(dst, b, h) do { _Pragma("unroll") for (int m = 0; m < 4; ++m) _Pragma("unroll") for (int k = 0; k < 2; ++k) dst[m][k] = *(const PG8_LAS bf16x8*)(lds + PG8_SA(b, h) + aoff + m * 2048 + k * 1024); } while (0)
#define PG8_LDB(dst, b, h) do { _Pragma("unroll") for (int n = 0; n < 2; ++n) _Pragma("unroll") for (int k = 0; k < 2; ++k) dst[n][k] = *(const PG8_LAS bf16x8*)(lds + PG8_SB(b, h) + boff + n * 2048 + k * 1024); } while (0)
#define PG8_MMA(ai, bj, At, Bt) do { __builtin_amdgcn_s_setprio(1); _Pragma("unroll") for (int m = 0; m < 4; ++m) _Pragma("unroll") for (int n = 0; n < 2; ++n) _Pragma("unroll") for (int k = 0; k < 2; ++k) \
        acc[ai][bj][m][n] = __builtin_amdgcn_mfma_f32_16x16x32_bf16(Bt[n][k], At[m][k], acc[ai][bj][m][n], 0, 0, 0); __builtin_amdgcn_s_setprio(0); } while (0)
#define PG8_WAIT_V(n) asm volatile("s_waitcnt vmcnt(" #n ")" ::: "memory")
#define PG8_WAIT_L(n) asm volatile("s_waitcnt lgkmcnt(" #n ")" ::: "memory")
#define PG8_BAR __builtin_amdgcn_s_barrier()
#define PG8_SCHED __builtin_amdgcn_sched_barrier(0)
    Unit cur, nxt; int ui = 0;
    if (!S.next(0, cur)) return;
    f32x4 acc[2][2][4][2];
#pragma unroll
    for (int a = 0; a < 2; ++a)
#pragma unroll
        for (int b = 0; b < 2; ++b)
#pragma unroll
            for (int m = 0; m < 4; ++m)
#pragma unroll
                for (int n = 0; n < 2; ++n) acc[a][b][m][n] = (f32x4){0.f, 0.f, 0.f, 0.f};
    bf16x8 At[4][2], B0[2][2], B1[2][2];
    const char* cA = (const char*)g.A + (size_t)cur.pm * tstep; const char* cB = (const char*)g.Bt + (size_t)cur.pn * tstep;
    S.a_ready(cur);
    if constexpr (SP2) {
        PG8_STAGE(PG8_SB(0, 0), cB, voffB); PG8_STAGE(PG8_SB(0, 1), cB + hstep, voffB); PG8_STAGE(PG8_SA(0, 0), cA, voffA); PG8_STAGE(PG8_SA(0, 1), cA + hstep, voffA);
        if (wr == 1) PG8_BAR;
        PG8_WAIT_V(2); PG8_BAR;
        PG8_STAGE(PG8_SB(1, 0), cB + kstep, voffB); PG8_STAGE(PG8_SA(1, 0), cA + kstep, voffA); PG8_STAGE(PG8_SB(1, 1), cB + hstep + kstep, voffB);
        PG8_WAIT_V(6); PG8_BAR;
    } else {
        PG8_STAGE(PG8_SB(0, 0), cB, voffB); PG8_STAGE(PG8_SA(0, 0), cA, voffA); PG8_STAGE(PG8_SB(0, 1), cB + hstep, voffB); PG8_STAGE(PG8_SA(0, 1), cA + hstep, voffA);
        if (wr == 1) PG8_BAR;
        PG8_WAIT_V(4); PG8_BAR;
        PG8_STAGE(PG8_SB(1, 0), cB + kstep, voffB); PG8_STAGE(PG8_SA(1, 0), cA + kstep, voffA); PG8_STAGE(PG8_SB(1, 1), cB + hstep + kstep, voffB);
        PG8_WAIT_V(6); PG8_BAR;
    }
    for (;;) {
        const bool has_next = S.next(ui + 1, nxt);
        const char* nA = has_next ? (const char*)g.A + (size_t)nxt.pm * tstep : cA; const char* nB = has_next ? (const char*)g.Bt + (size_t)nxt.pn * tstep : cB;
        for (int t = 0; t < nt; t += 2) {
            const bool last = (t == nt - 2);
            const char* a1 = cA + (size_t)(t + 1) * kstep;
            const char* a2 = last ? nA : cA + (size_t)(t + 2) * kstep; const char* b2 = last ? nB : cB + (size_t)(t + 2) * kstep;
            const char* a3 = a2 + kstep; const char* b3 = b2 + kstep;
            if (last && has_next) S.a_ready(nxt);
            if constexpr (SP2) {
            PG8_LDB(B0, 0, 0); PG8_LDB(B1, 0, 1); PG8_SCHED; PG8_LDA(At, 0, 0); PG8_STAGE(PG8_SA(1, 1), a1 + hstep, voffA);
            PG8_WAIT_V(8); PG8_WAIT_L(0); PG8_BAR; PG8_MMA(0, 0, At, B0); PG8_MMA(0, 1, At, B1); PG8_BAR; PG8_SCHED;
            PG8_LDA(At, 0, 1); PG8_STAGE(PG8_SB(0, 0), b2, voffB); PG8_STAGE(PG8_SB(0, 1), b2 + hstep, voffB); PG8_STAGE(PG8_SA(0, 0), a2, voffA);
            PG8_WAIT_V(8); PG8_WAIT_L(0); PG8_BAR; PG8_MMA(1, 0, At, B0); PG8_MMA(1, 1, At, B1); PG8_BAR; PG8_SCHED;
            PG8_LDB(B0, 1, 0); PG8_LDB(B1, 1, 1); PG8_SCHED; PG8_LDA(At, 1, 0); PG8_STAGE(PG8_SA(0, 1), a2 + hstep, voffA);
            PG8_WAIT_V(8); PG8_WAIT_L(0); PG8_BAR; PG8_MMA(0, 0, At, B0); PG8_MMA(0, 1, At, B1); PG8_BAR; PG8_SCHED;
            PG8_LDA(At, 1, 1); PG8_STAGE(PG8_SB(1, 0), b3, voffB); PG8_STAGE(PG8_SB(1, 1), b3 + hstep, voffB); PG8_STAGE(PG8_SA(1, 0), a3, voffA);
            PG8_WAIT_V(8); PG8_WAIT_L(0); PG8_BAR; PG8_MMA(1, 0, At, B0); PG8_MMA(1, 1, At, B1); PG8_BAR; PG8_SCHED;
            } else {
            PG8_LDB(B0, 0, 0); PG8_SCHED; PG8_LDA(At, 0, 0); PG8_STAGE(PG8_SA(1, 1), a1 + hstep, voffA);
            PG8_WAIT_L(8); PG8_BAR; PG8_WAIT_L(0); PG8_MMA(0, 0, At, B0); PG8_BAR; PG8_SCHED;
            PG8_LDB(B1, 0, 1); PG8_STAGE(PG8_SB(0, 0), b2, voffB);
            PG8_BAR; PG8_WAIT_L(0); PG8_MMA(0, 1, At, B1); PG8_BAR;
            PG8_LDA(At, 0, 1); PG8_STAGE(PG8_SA(0, 0), a2, voffA);
            PG8_BAR; PG8_WAIT_L(0); PG8_MMA(1, 0, At, B0); PG8_BAR; PG8_SCHED;
            PG8_STAGE(PG8_SB(0, 1), b2 + hstep, voffB);
            PG8_WAIT_V(6); PG8_BAR; PG8_MMA(1, 1, At, B1); PG8_BAR;
            PG8_LDB(B0, 1, 0); PG8_SCHED; PG8_LDA(At, 1, 0); PG8_STAGE(PG8_SA(0, 1), a2 + hstep, voffA);
            PG8_WAIT_L(8); PG8_BAR; PG8_WAIT_L(0); PG8_MMA(0, 0, At, B0); PG8_BAR; PG8_SCHED;
            PG8_LDB(B1, 1, 1); PG8_STAGE(PG8_SB(1, 0), b3, voffB);
            PG8_BAR; PG8_WAIT_L(0); PG8_MMA(0, 1, At, B1); PG8_BAR;
            PG8_LDA(At, 1, 1); PG8_STAGE(PG8_SA(1, 0), a3, voffA);
            PG8_BAR; PG8_WAIT_L(0); PG8_MMA(1, 0, At, B0); PG8_BAR; PG8_SCHED;
            PG8_STAGE(PG8_SB(1, 1), b3 + hstep, voffB);
            PG8_WAIT_V(6); PG8_BAR; PG8_MMA(1, 1, At, B1); PG8_BAR;
            }
        }
        if constexpr (ALIGN_EPI) { if (wr == 0) PG8_BAR; }
        if constexpr (!Epi::AFTER_DRAIN) { E(acc, cur, wr, wc, fr, fq); S.done(cur); }
        if (!has_next) break;
#pragma unroll
        for (int a = 0; a < 2; ++a)
#pragma unroll
            for (int b = 0; b < 2; ++b)
#pragma unroll
                for (int m = 0; m < 4; ++m)
#pragma unroll
                    for (int n = 0; n < 2; ++n) acc[a][b][m][n] = (f32x4){0.f, 0.f, 0.f, 0.f};
        cur = nxt; cA = nA; cB = nB; ++ui;
        if constexpr (ALIGN_EPI) { if (wr == 1) PG8_BAR; }
    }
    PG8_WAIT_V(0);
    if constexpr (!ALIGN_EPI) { if (wr == 0) PG8_BAR; }
    PG8_BAR;
    if constexpr (Epi::AFTER_DRAIN) { E.fused(acc, cur, wr, wc, fr, fq, lds, wid, lane); S.done(cur); }
#undef PG8_SA
#undef PG8_SB
#undef PG8_STAGE
#undef PG8_LDA
#undef PG8_LDB
#undef PG8_MMA
#undef PG8_WAIT_V
#undef PG8_WAIT_L
#undef PG8_BAR
#undef PG8_SCHED
}
}
#define LAS __attribute__((address_space(3)))
typedef unsigned short bf16_t;
typedef short bf16x8 __attribute__((ext_vector_type(8)));
typedef short s16x4 __attribute__((ext_vector_type(4)));
typedef float f32x4 __attribute__((ext_vector_type(4)));
typedef float f32x16 __attribute__((ext_vector_type(16)));
typedef unsigned u32x4 __attribute__((ext_vector_type(4)));
typedef unsigned u32x2 __attribute__((ext_vector_type(2)));

constexpr int T_ = 16384, SEQ_ = 4096, NB_ = 4, DM_ = 1024, DFF_ = 2816, MEMT_ = 1024;
constexpr int NWAVES = 8, NTHREADS = 512;
constexpr int LDS_BYTES = 155648;
constexpr size_t MiB = 1u << 20;
constexpr size_t WS_KX = 1 * MiB, WS_VXT = 3 * MiB, WS_DTT = 5 * MiB, WS_WIN = 7 * MiB, WS_ABUF = 24 * MiB, WS_Q = 56 * MiB, WS_K = 88 * MiB, WS_VT = 120 * MiB;
constexpr size_t WS_Z = 88 * MiB, WS_XS = 152 * MiB, WS_BC = 216 * MiB;
constexpr size_t WS_HBUF = 56 * MiB, WS_YBUF_A = 152 * MiB, WS_YBUF_B = 88 * MiB;
constexpr size_t WS_WGU = 216 * MiB, WS_WD = 227 * MiB, WS_WKV = 233 * MiB, WS_MEMN = 237 * MiB;
constexpr size_t WS_WG = 7 * MiB, WS_WBA = 11 * MiB, WS_WBS = 13 * MiB, WS_WMO = 17 * MiB, WS_WQ = 19 * MiB, WS_WO = 21 * MiB;
constexpr size_t WS_GA = 152 * MiB, WS_GS = 184 * MiB, WS_TMP = 216 * MiB, WS_QX = 56 * MiB, WS_XO = 152 * MiB;
constexpr size_t WS_NEED = 248 * MiB;

__device__ __forceinline__ float wave_sum(float v) {
#pragma unroll
    for (int o = 1; o < 64; o <<= 1) v += __shfl_xor(v, o);
    return v;
}
typedef float f32x2_t __attribute__((ext_vector_type(2))); typedef __bf16 bf16x2_t __attribute__((ext_vector_type(2)));
__device__ __forceinline__ unsigned pk2(float lo, float hi) { f32x2_t v = {lo, hi}; bf16x2_t b = __builtin_convertvector(v, bf16x2_t); return __builtin_bit_cast(unsigned, b); }
__device__ __forceinline__ unsigned short bf1(float x) { return (unsigned short)(pk2(x, 0.f) & 0xffffu); }
__device__ __forceinline__ float bflo(unsigned w) { return __uint_as_float(w << 16); }
__device__ __forceinline__ float bfhi(unsigned w) { return __uint_as_float(w & 0xffff0000u); }
__device__ __forceinline__ float bf2f(unsigned short h) { return __uint_as_float(((unsigned)h) << 16); }
__device__ __forceinline__ float fsigm(float x) { return __builtin_amdgcn_rcpf(1.0f + __builtin_amdgcn_exp2f(-1.4426950408889634f * x)); }
__device__ __forceinline__ int crow(int r, int hi) { return (r & 3) + 8 * (r >> 2) + 4 * hi; }
#define MFMA32(a, b, c) __builtin_amdgcn_mfma_f32_32x32x16_bf16((a), (b), (c), 0, 0, 0)

__device__ __forceinline__ void tr_job(const float* W, int K, int N, int ncol0, int ncols, bf16_t* WT, int mode, LAS float* scr, int gw, int NGW, int lane, int& itbase) {
    const int nblk = ncols / 32, nitems = (K / 64) * nblk;
    int first = (gw - (itbase % NGW) + NGW) % NGW;
    for (int it = first; it < nitems; it += NGW) {
        const int kb = it / nblk, nb = it % nblk, k0 = 64 * kb, n0 = ncol0 + 32 * nb;
        int drow0;
        if (mode == 0) drow0 = n0 - ncol0;
        else { const int c = n0 < DFF_ ? n0 : n0 - DFF_; drow0 = 256 * (c / 128) + (c % 128) + (n0 < DFF_ ? 0 : 128); }
#pragma unroll
        for (int i = 0; i < 8; ++i) { const int kk = 8 * i + (lane >> 3), n4 = 4 * (lane & 7); const f32x4 v = __builtin_nontemporal_load((const f32x4*)(W + (size_t)(k0 + kk) * N + n0 + n4));
            scr[kk * 33 + n4] = v.x; scr[kk * 33 + n4 + 1] = v.y; scr[kk * 33 + n4 + 2] = v.z; scr[kk * 33 + n4 + 3] = v.w; }
        asm volatile("s_waitcnt lgkmcnt(0)" ::: "memory");
        const int c = lane & 7;
#pragma unroll
        for (int j = 0; j < 4; ++j) { const int n = (lane >> 3) + 8 * j; const LAS float* s = scr + (8 * c) * 33 + n;
            u32x4 o; o.x = pk2(s[0 * 33], s[1 * 33]); o.y = pk2(s[2 * 33], s[3 * 33]); o.z = pk2(s[4 * 33], s[5 * 33]); o.w = pk2(s[6 * 33], s[7 * 33]);
            *(u32x4*)(WT + (size_t)(drow0 + n) * K + k0 + 8 * c) = o; }
        asm volatile("s_waitcnt lgkmcnt(0)" ::: "memory");
    }
    itbase += nitems;
}

template <bool BF> __device__ __forceinline__ void load_row(f32x4 (&r)[4], const void* base, size_t m, int lane) {
    if (BF) { const u32x2* p = (const u32x2*)((const bf16_t*)base + m * DM_) + lane;
#pragma unroll
        for (int j = 0; j < 4; ++j) { const u32x2 w = p[64 * j]; r[j] = (f32x4){bflo(w.x), bfhi(w.x), bflo(w.y), bfhi(w.y)}; } }
    else { const f32x4* p = (const f32x4*)((const float*)base + m * DM_) + lane;
#pragma unroll
        for (int j = 0; j < 4; ++j) r[j] = p[64 * j]; }
}
__device__ __forceinline__ void add_normed(f32x4 (&r)[4], const bf16_t* y, size_t m, const float* gpost, float coef, int lane) {
    const u32x2* yr = (const u32x2*)(y + m * DM_) + lane; f32x4 v[4]; float s = 0.f;
#pragma unroll
    for (int j = 0; j < 4; ++j) { const u32x2 w = __builtin_nontemporal_load(yr + 64 * j); v[j] = (f32x4){bflo(w.x), bfhi(w.x), bflo(w.y), bfhi(w.y)}; s += (v[j].x * v[j].x + v[j].y * v[j].y) + (v[j].z * v[j].z + v[j].w * v[j].w); }
    const float rs = coef * __builtin_amdgcn_rsqf(wave_sum(s) * (1.f / DM_) + 1e-6f);
#pragma unroll
    for (int j = 0; j < 4; ++j) { const f32x4 g = ((const f32x4*)gpost)[lane + 64 * j]; r[j] = r[j] + v[j] * g * rs; }
}
template <bool RIN_BF, bool ROUT_BF>
__device__ __forceinline__ void rowwise(const bf16_t* y, const void* rin, const float* gpost, float coef, void* rout, const float* gpre, bf16_t* aout, int rows, int gw, int NGW, int lane) {
    const int per = (rows + NGW - 1) / NGW;
    for (int m = gw * per; m < gw * per + per && m < rows; ++m) {
        f32x4 r[4];
        load_row<RIN_BF>(r, rin, (size_t)m, lane);
        if (y) add_normed(r, y, (size_t)m, gpost, coef, lane);
        if (rout) {
            if (ROUT_BF) { u32x2* o = (u32x2*)((bf16_t*)rout + (size_t)m * DM_) + lane;
#pragma unroll
                for (int j = 0; j < 4; ++j) { u32x2 w; w.x = pk2(r[j].x, r[j].y); w.y = pk2(r[j].z, r[j].w); o[64 * j] = w; } }
            else { f32x4* o = (f32x4*)((float*)rout + (size_t)m * DM_) + lane;
#pragma unroll
                for (int j = 0; j < 4; ++j) o[64 * j] = r[j]; }
        }
        if (aout) {
            float s = 0.f;
#pragma unroll
            for (int j = 0; j < 4; ++j) s += (r[j].x * r[j].x + r[j].y * r[j].y) + (r[j].z * r[j].z + r[j].w * r[j].w);
            const float rs = __builtin_amdgcn_rsqf(wave_sum(s) * (1.f / DM_) + 1e-6f);
            u32x2* o = (u32x2*)(aout + (size_t)m * DM_) + lane;
#pragma unroll
            for (int j = 0; j < 4; ++j) { const f32x4 g = ((const f32x4*)gpre)[lane + 64 * j]; const f32x4 v = r[j] * g * rs; u32x2 w; w.x = pk2(v.x, v.y); w.y = pk2(v.z, v.w); o[64 * j] = w; }
        }
    }
}
__device__ __forceinline__ void groupnorm_rows(bf16_t* yb, const float* g, int rows, int gw, int NGW, int lane) {
    const int per = (rows + NGW - 1) / NGW;
    for (int m = gw * per; m < gw * per + per && m < rows; ++m) {
        u32x4 w[4];
#pragma unroll
        for (int j = 0; j < 4; ++j) w[j] = *((const u32x4*)(yb + (size_t)m * 2048 + j * 512) + lane);
#pragma unroll
        for (int j = 0; j < 4; ++j) {
            float v[8] = {bflo(w[j].x), bfhi(w[j].x), bflo(w[j].y), bfhi(w[j].y), bflo(w[j].z), bfhi(w[j].z), bflo(w[j].w), bfhi(w[j].w)};
            float s = 0.f;
#pragma unroll
            for (int k = 0; k < 8; ++k) s += v[k] * v[k];
            const float rs = __builtin_amdgcn_rsqf(wave_sum(s) * (1.f / 512.f) + 1e-5f);
            const f32x4 g0 = *(const f32x4*)(g + j * 512 + lane * 8), g1 = *(const f32x4*)(g + j * 512 + lane * 8 + 4);
            u32x4 o; o.x = pk2(v[0] * rs * g0.x, v[1] * rs * g0.y); o.y = pk2(v[2] * rs * g0.z, v[3] * rs * g0.w); o.z = pk2(v[4] * rs * g1.x, v[5] * rs * g1.y); o.w = pk2(v[6] * rs * g1.z, v[7] * rs * g1.w);
            w[j] = o;
        }
#pragma unroll
        for (int j = 0; j < 4; ++j) *((u32x4*)(yb + (size_t)m * 2048 + j * 512) + lane) = w[j];
    }
}

template <int DQK, bool CAUSAL, bool PREFETCH>
__device__ __forceinline__ void flash_pass(f32x16 (&o)[4], const bf16_t* Qrow, const bf16_t* Kbase, int kpitch, const bf16_t* VTbase, int vpitch, int NT, int qpos0, float cscale, LAS unsigned char* lds, int wid, int lane) {
    constexpr int KP = DQK + 8, ND = DQK / 16, KL = DQK / 64, KC = DQK / 8;
    const int tid = threadIdx.x, r32 = lane & 31, hi = lane >> 5;
    constexpr int KSB = 64 * KP * 2, BUFB = KSB + 18432;
    LAS bf16_t* Ks = (LAS bf16_t*)lds; LAS bf16_t* Vs = (LAS bf16_t*)(lds + KSB); volatile LAS float* wsf = (volatile LAS float*)(lds + 2 * BUFB) + wid * 64;
    constexpr bool QREG = (DQK <= 64);
    bf16x8 qf[QREG ? ND : 1];
    if (QREG) {
#pragma unroll
        for (int d0 = 0; d0 < ND; ++d0) qf[d0] = *(const bf16x8*)(Qrow + d0 * 16 + hi * 8);
    }
#pragma unroll
    for (int eb = 0; eb < 4; ++eb)
#pragma unroll
        for (int r = 0; r < 16; ++r) o[eb][r] = 0.f;
    float mrun = -1e30f, lrun = 0.f;
    u32x4 kst[KL], vst[2];
#pragma unroll
    for (int i = 0; i < KL; ++i) { const int ci = tid + NTHREADS * i, row = ci / KC, cc = ci % KC; kst[i] = *(const u32x4*)(Kbase + (size_t)row * kpitch + cc * 8); }
#pragma unroll
    for (int i = 0; i < 2; ++i) { const int ci = tid + NTHREADS * i, e = ci >> 3, cc = ci & 7; vst[i] = *(const u32x4*)(VTbase + (size_t)e * vpitch + cc * 8); }
#pragma unroll
    for (int i = 0; i < KL; ++i) { const int ci = tid + NTHREADS * i, row = ci / KC, cc = ci % KC; *(LAS u32x4*)(Ks + row * KP + cc * 8) = kst[i]; }
#pragma unroll
    for (int i = 0; i < 2; ++i) { const int ci = tid + NTHREADS * i, e = ci >> 3, cc = ci & 7; { LAS bf16_t* vd = Vs + e * 72 + (cc >> 1) * 16 + (cc & 1) * 4; *(LAS u32x2*)vd = (u32x2){vst[i].x, vst[i].y}; *(LAS u32x2*)(vd + 8) = (u32x2){vst[i].z, vst[i].w}; } }
    __syncthreads();
    for (int t = 0; t < NT; ++t) {
        Ks = (LAS bf16_t*)(lds + (t & 1) * BUFB); Vs = (LAS bf16_t*)(lds + (t & 1) * BUFB + KSB);
        if (PREFETCH && t + 1 < NT) {
#pragma unroll
            for (int i = 0; i < KL; ++i) { const int ci = tid + NTHREADS * i, row = ci / KC, cc = ci % KC; kst[i] = *(const u32x4*)(Kbase + (size_t)(64 * (t + 1) + row) * kpitch + cc * 8); }
#pragma unroll
            for (int i = 0; i < 2; ++i) { const int ci = tid + NTHREADS * i, e = ci >> 3, cc = ci & 7; vst[i] = *(const u32x4*)(VTbase + (size_t)e * vpitch + 64 * (t + 1) + cc * 8); }
        }
        const bool active = !CAUSAL || (64 * t <= qpos0 + 31);
        if (active) {
            f32x16 p0, p1;
#pragma unroll
            for (int r = 0; r < 16; ++r) { p0[r] = 0.f; p1[r] = 0.f; }
            if (QREG) {
#pragma unroll
                for (int d0 = 0; d0 < ND; ++d0) {
                    const bf16x8 k0 = *(const LAS bf16x8*)(Ks + r32 * KP + d0 * 16 + hi * 8);
                    const bf16x8 k1 = *(const LAS bf16x8*)(Ks + (32 + r32) * KP + d0 * 16 + hi * 8);
                    p0 = MFMA32(k0, qf[d0], p0); p1 = MFMA32(k1, qf[d0], p1);
                }
            } else {
#pragma unroll 1
                for (int dc = 0; dc < ND; dc += 8) {
                    bf16x8 q4[8];
#pragma unroll
                    for (int i = 0; i < 8; ++i) q4[i] = *(const bf16x8*)(Qrow + (dc + i) * 16 + hi * 8);
#pragma unroll
                    for (int i = 0; i < 8; ++i) {
                        const bf16x8 k0 = *(const LAS bf16x8*)(Ks + r32 * KP + (dc + i) * 16 + hi * 8);
                        const bf16x8 k1 = *(const LAS bf16x8*)(Ks + (32 + r32) * KP + (dc + i) * 16 + hi * 8);
                        p0 = MFMA32(k0, q4[i], p0); p1 = MFMA32(k1, q4[i], p1);
                    }
                }
            }
            if (CAUSAL && (64 * t + 63 > qpos0)) {
                const int qp = qpos0 + r32;
#pragma unroll
                for (int r = 0; r < 16; ++r) { const int kv = 64 * t + crow(r, hi); if (kv > qp) p0[r] = -1e30f; if (kv + 32 > qp) p1[r] = -1e30f; }
            }
            float mt = fmaxf(p0[0], p1[0]);
#pragma unroll
            for (int r = 1; r < 16; ++r) mt = fmaxf(mt, fmaxf(p0[r], p1[r]));
            mt = fmaxf(mt, __shfl_xor(mt, 32));
            const bool grow = __any(mt > mrun + 8.0f / cscale);
            float alpha = 1.0f;
            if (grow) { const float mn = fmaxf(mrun, mt); alpha = __builtin_amdgcn_exp2f((mrun - mn) * cscale); mrun = mn; }
            const float mnc = -mrun * cscale;
            float rs = 0.f;
#pragma unroll
            for (int r = 0; r < 16; ++r) { p0[r] = __builtin_amdgcn_exp2f(__builtin_fmaf(p0[r], cscale, mnc)); p1[r] = __builtin_amdgcn_exp2f(__builtin_fmaf(p1[r], cscale, mnc)); rs += p0[r] + p1[r]; }
            lrun = lrun * alpha + rs;
            if (grow) {
                if (hi == 0) wsf[r32] = alpha;
                asm volatile("s_waitcnt lgkmcnt(0)" ::: "memory");
#pragma unroll
                for (int r = 0; r < 16; ++r) { const float a = wsf[crow(r, hi)];
#pragma unroll
                    for (int eb = 0; eb < 4; ++eb) o[eb][r] *= a; }
            }
#pragma unroll
            for (int half = 0; half < 2; ++half)
#pragma unroll
                for (int rr = 0; rr < 2; ++rr) {
                    u32x4 pw;
                    if (half == 0) { pw.x = pk2(p0[8 * rr + 0], p0[8 * rr + 1]); pw.y = pk2(p0[8 * rr + 2], p0[8 * rr + 3]); pw.z = pk2(p0[8 * rr + 4], p0[8 * rr + 5]); pw.w = pk2(p0[8 * rr + 6], p0[8 * rr + 7]); }
                    else           { pw.x = pk2(p1[8 * rr + 0], p1[8 * rr + 1]); pw.y = pk2(p1[8 * rr + 2], p1[8 * rr + 3]); pw.z = pk2(p1[8 * rr + 4], p1[8 * rr + 5]); pw.w = pk2(p1[8 * rr + 6], p1[8 * rr + 7]); }
                    const bf16x8 pa = __builtin_bit_cast(bf16x8, pw);
#pragma unroll
                    for (int eb = 0; eb < 4; ++eb) {
                        const bf16x8 vb = *(const LAS bf16x8*)(Vs + (32 * eb + r32) * 72 + 32 * half + 16 * rr + 8 * hi);
                        o[eb] = MFMA32(pa, vb, o[eb]);
                    }
                }
        }
        if (t + 1 < NT) {
            LAS bf16_t* Kn = (LAS bf16_t*)(lds + ((t + 1) & 1) * BUFB); LAS bf16_t* Vn = (LAS bf16_t*)(lds + ((t + 1) & 1) * BUFB + KSB);
            if (!PREFETCH) {
#pragma unroll
                for (int i = 0; i < KL; ++i) { const int ci = tid + NTHREADS * i, row = ci / KC, cc = ci % KC; kst[i] = *(const u32x4*)(Kbase + (size_t)(64 * (t + 1) + row) * kpitch + cc * 8); }
#pragma unroll
                for (int i = 0; i < 2; ++i) { const int ci = tid + NTHREADS * i, e = ci >> 3, cc = ci & 7; vst[i] = *(const u32x4*)(VTbase + (size_t)e * vpitch + 64 * (t + 1) + cc * 8); }
            }
#pragma unroll
            for (int i = 0; i < KL; ++i) { const int ci = tid + NTHREADS * i, row = ci / KC, cc = ci % KC; *(LAS u32x4*)(Kn + row * KP + cc * 8) = kst[i]; }
#pragma unroll
            for (int i = 0; i < 2; ++i) { const int ci = tid + NTHREADS * i, e = ci >> 3, cc = ci & 7; { LAS bf16_t* vd = Vn + e * 72 + (cc >> 1) * 16 + (cc & 1) * 4; *(LAS u32x2*)vd = (u32x2){vst[i].x, vst[i].y}; *(LAS u32x2*)(vd + 8) = (u32x2){vst[i].z, vst[i].w}; } }
        }
        __syncthreads();
    }
    lrun += __shfl_xor(lrun, 32);
    if (hi == 0) wsf[r32] = __builtin_amdgcn_rcpf(lrun);
    asm volatile("s_waitcnt lgkmcnt(0)" ::: "memory");
#pragma unroll
    for (int r = 0; r < 16; ++r) { const float a = wsf[crow(r, hi)];
#pragma unroll
        for (int eb = 0; eb < 4; ++eb) o[eb][r] *= a; }
    asm volatile("s_waitcnt lgkmcnt(0)" ::: "memory");
}

__device__ __forceinline__ void diffattn_unit(int b, int h, int qb, const bf16_t* Q, const bf16_t* Kb, const bf16_t* VT, bf16_t* O, float lam, const float* subg, LAS unsigned char* lds, int wid, int lane) {
    const int r32 = lane & 31, hi = lane >> 5;
    const int q0 = 256 * qb, qpos0 = q0 + 32 * wid;
    const size_t trow = (size_t)b * SEQ_ + qpos0 + r32;
    const int NT = 4 * (qb + 1);
    const float cs = 0.125f * 1.4426950408889634f;
    f32x16 o1[4];
    flash_pass<64, true, true>(o1, Q + trow * 1024 + h * 128, Kb + (size_t)b * SEQ_ * 1024 + h * 128, 1024, VT + (size_t)(h * 128) * T_ + (size_t)b * SEQ_, T_, NT, qpos0, cs, lds, wid, lane);
    volatile LAS unsigned* st = (volatile LAS unsigned*)(lds + 57344) + wid * 2048 + lane;
#pragma unroll
    for (int r = 0; r < 16; ++r) { st[(2 * r) * 64] = pk2(o1[0][r], o1[1][r]); st[(2 * r + 1) * 64] = pk2(o1[2][r], o1[3][r]); }
    flash_pass<64, true, true>(o1, Q + trow * 1024 + h * 128 + 64, Kb + (size_t)b * SEQ_ * 1024 + h * 128 + 64, 1024, VT + (size_t)(h * 128) * T_ + (size_t)b * SEQ_, T_, NT, qpos0, cs, lds, wid, lane);
    float gsub[4];
#pragma unroll
    for (int eb = 0; eb < 4; ++eb) gsub[eb] = subg[32 * eb + r32] * 0.8f;
#pragma unroll
    for (int r = 0; r < 16; ++r) {
        const unsigned w0 = st[(2 * r) * 64], w1 = st[(2 * r + 1) * 64];
        float v[4] = {bflo(w0) - lam * o1[0][r], bfhi(w0) - lam * o1[1][r], bflo(w1) - lam * o1[2][r], bfhi(w1) - lam * o1[3][r]};
        float ss = (v[0] * v[0] + v[1] * v[1]) + (v[2] * v[2] + v[3] * v[3]);
#pragma unroll
        for (int off = 1; off < 32; off <<= 1) ss += __shfl_xor(ss, off);
        const float rs = __builtin_amdgcn_rsqf(ss * (1.f / 128.f) + 1e-5f);
        bf16_t* orow = O + ((size_t)b * SEQ_ + qpos0 + crow(r, hi)) * 1024 + h * 128 + r32;
#pragma unroll
        for (int eb = 0; eb < 4; ++eb) orow[32 * eb] = bf1(v[eb] * rs * gsub[eb]);
    }
}
__device__ __forceinline__ void xattn_unit(int b, int h, int qb, int dh, const bf16_t* QX, const bf16_t* KX, const bf16_t* VXT, bf16_t* XO, LAS unsigned char* lds, int wid, int lane) {
    const int r32 = lane & 31, hi = lane >> 5;
    const int qpos0 = 256 * qb + 32 * wid;
    const size_t trow = (size_t)b * SEQ_ + qpos0 + r32;
    f32x16 o[4];
    flash_pass<256, false, true>(o, QX + trow * 1024 + h * 256, KX + (size_t)b * 256 * 1024 + h * 256, 1024, VXT + (size_t)(h * 256 + dh * 128) * MEMT_ + b * 256, MEMT_, 4, 0, 0.0625f * 1.4426950408889634f, lds, wid, lane);
#pragma unroll
    for (int r = 0; r < 16; ++r) {
        bf16_t* orow = XO + ((size_t)b * SEQ_ + qpos0 + crow(r, hi)) * 1024 + h * 256 + dh * 128 + r32;
#pragma unroll
        for (int eb = 0; eb < 4; ++eb) orow[32 * eb] = bf1(o[eb][r]);
    }
}

constexpr int SP = 136;
constexpr int SOFF_BM = 0, SOFF_BT = 34816, SOFF_CM = 69632, SOFF_XT = 104448, SOFF_SB = 121856, SOFF_F = 139264, SOFF_CW = 141824;
template <int STR>
__device__ __forceinline__ void conv8(const u32x4 (&u)[4], const LAS float* cwb, float (&out)[8]) {
#pragma unroll
    for (int k = 0; k < 8; ++k) {
        float acc = cwb[(k * 5 + 4) * STR];
#pragma unroll
        for (int j = 0; j < 4; ++j) { const unsigned w = (k >> 1) == 0 ? u[j].x : (k >> 1) == 1 ? u[j].y : (k >> 1) == 2 ? u[j].z : u[j].w; const float v = (k & 1) ? bfhi(w) : bflo(w); acc += cwb[(k * 5 + j) * STR] * v; }
        out[k] = acc * fsigm(acc);
    }
}
__device__ __forceinline__ void ssd_unit(int b, int h, const bf16_t* XS, const bf16_t* BC, bf16_t* Z, const float* dtT, const float* conv_w, const float* conv_b, const float* A_log, const float* Dp, LAS unsigned char* lds, int wid, int lane) {
    const int tid = threadIdx.x, r32 = lane & 31, hi = lane >> 5, g = h >> 3;
    LAS bf16_t* Bm = (LAS bf16_t*)(lds + SOFF_BM); LAS bf16_t* BT = (LAS bf16_t*)(lds + SOFF_BT); LAS bf16_t* Cm = (LAS bf16_t*)(lds + SOFF_CM);
    LAS bf16_t* XT = (LAS bf16_t*)(lds + SOFF_XT); LAS bf16_t* Sb = (LAS bf16_t*)(lds + SOFF_SB);
    LAS float* acs = (LAS float*)(lds + SOFF_F); LAS float* dec = acs + 128; LAS float* eacs = acs + 256; LAS float* ddt = acs + 384; LAS float* cw = (LAS float*)(lds + SOFF_CW);
    const float a_h = -__expf(A_log[h]), D_h = Dp[h];
    for (int i = tid; i < 1600; i += NTHREADS) {
        int ci, kj;
        if (i < 320) { kj = i >> 3; ci = (i & 7) * 8 + kj / 5; } else if (i < 960) { const int q = i - 320; kj = q >> 4; ci = 64 + (q & 15) * 8 + kj / 5; } else { const int q = i - 960; kj = q >> 4; ci = 192 + (q & 15) * 8 + kj / 5; }
        const int j = kj % 5; const int ch = ci < 64 ? h * 64 + ci : ci < 192 ? 2048 + g * 128 + (ci - 64) : 2560 + g * 128 + (ci - 192);
        cw[i] = j < 4 ? conv_w[j * 3072 + ch] : conv_b[ch]; }
    for (int i = tid; i < 64 * SP / 2; i += NTHREADS) ((LAS unsigned*)Sb)[i] = 0u;
    f32x16 S;
#pragma unroll
    for (int r = 0; r < 16; ++r) S[r] = 0.f;
    __syncthreads();
    float dn0 = dtT[(size_t)h * T_ + (size_t)b * SEQ_ + 2 * lane], dn1 = dtT[(size_t)h * T_ + (size_t)b * SEQ_ + 2 * lane + 1];
    for (int c = 0; c < 32; ++c) {
        const int s0 = 128 * c; const size_t t0 = (size_t)b * SEQ_ + s0;
        if (wid == 0) {
            const float d0 = dn0, d1 = dn1;
            if (c + 1 < 32) { dn0 = dtT[(size_t)h * T_ + t0 + 128 + 2 * lane]; dn1 = dtT[(size_t)h * T_ + t0 + 128 + 2 * lane + 1]; }
            const float a0 = a_h * d0, a1 = a_h * d1; const float pr = a0 + a1; float inc = pr;
#pragma unroll
            for (int off = 1; off < 64; off <<= 1) { const float n = __shfl_up(inc, off); if (lane >= off) inc += n; }
            const float exc = inc - pr, tot = __shfl(inc, 63);
            const float c0 = exc + a0, c1 = inc;
            acs[2 * lane] = c0; acs[2 * lane + 1] = c1; dec[2 * lane] = __expf(tot - c0); dec[2 * lane + 1] = __expf(tot - c1);
            eacs[2 * lane] = __expf(c0); eacs[2 * lane + 1] = __expf(c1); ddt[2 * lane] = D_h / fmaxf(d0, 1e-30f); ddt[2 * lane + 1] = D_h / fmaxf(d1, 1e-30f);
        }
        {
            u32x4 wb[4], wc_[4];
#pragma unroll
            for (int i = 0; i < 4; ++i) { const int item = tid + NTHREADS * i, l = item >> 4, n8 = item & 15; const bf16_t* p = BC + (t0 + l) * 1024 + g * 128 + n8 * 8; wb[i] = *(const u32x4*)p; wc_[i] = *(const u32x4*)(p + 512); }
#pragma unroll
            for (int i = 0; i < 4; ++i) { const int item = tid + NTHREADS * i, l = item >> 4, n8 = item & 15;
                *(LAS u32x4*)(Bm + l * SP + n8 * 8) = wb[i]; *(LAS u32x4*)(Cm + l * SP + n8 * 8) = wc_[i];
                const unsigned short e[8] = {(unsigned short)(wb[i].x & 0xffffu), (unsigned short)(wb[i].x >> 16), (unsigned short)(wb[i].y & 0xffffu), (unsigned short)(wb[i].y >> 16),
                                             (unsigned short)(wb[i].z & 0xffffu), (unsigned short)(wb[i].z >> 16), (unsigned short)(wb[i].w & 0xffffu), (unsigned short)(wb[i].w >> 16)};
#pragma unroll
                for (int k = 0; k < 8; ++k) BT[(n8 * 8 + k) * SP + (l ^ (n8 << 3))] = e[k]; }
        }
        {
            u32x4 ux[2][4]; float dtl[2];
#pragma unroll
            for (int i = 0; i < 2; ++i) { const int item = tid + NTHREADS * i, l = item >> 3, p8 = item & 7;
                dtl[i] = dtT[(size_t)h * T_ + t0 + l];
#pragma unroll
                for (int j = 0; j < 4; ++j) { const int sp = s0 + l - 3 + j;
                    if (sp >= 0) ux[i][j] = *(const u32x4*)(XS + (t0 + l - 3 + j) * 2048 + h * 64 + p8 * 8); else ux[i][j] = (u32x4){0u, 0u, 0u, 0u}; } }
#pragma unroll
            for (int i = 0; i < 2; ++i) { const int item = tid + NTHREADS * i, l = item >> 3, p8 = item & 7;
                float vx[8]; conv8<8>(ux[i], cw + p8, vx);
#pragma unroll
                for (int k = 0; k < 8; ++k) XT[(p8 * 8 + k) * SP + (l ^ (p8 << 3))] = bf1(vx[k] * dtl[i]); }
        }
        __syncthreads();
        f32x16 cb[2];
#pragma unroll
        for (int q = 0; q < 2; ++q) {
            const int idx = wid + 8 * q;
            if (idx < 10) {
                const int lb = idx < 1 ? 0 : idx < 3 ? 1 : idx < 6 ? 2 : 3; const int sb = idx - (lb * (lb + 1)) / 2;
                f32x16 acc;
#pragma unroll
                for (int r = 0; r < 16; ++r) acc[r] = 0.f;
#pragma unroll
                for (int kk = 0; kk < 8; ++kk) { const bf16x8 af = *(const LAS bf16x8*)(Cm + (32 * lb + r32) * SP + 16 * kk + 8 * hi); const bf16x8 bfm = *(const LAS bf16x8*)(Bm + (32 * sb + r32) * SP + 16 * kk + 8 * hi); acc = MFMA32(af, bfm, acc); }
                const int s = 32 * sb + r32; const float as = acs[s];
#pragma unroll
                for (int r = 0; r < 16; ++r) { const int l = 32 * lb + crow(r, hi); const float e = __expf(fminf(acs[l] - as, 0.f)); acc[r] = l >= s ? acc[r] * e : 0.f; }
                cb[q] = acc;
            }
        }
        __syncthreads();
#pragma unroll
        for (int q = 0; q < 2; ++q) {
            const int idx = wid + 8 * q;
            if (idx < 10) {
                const int lb = idx < 1 ? 0 : idx < 3 ? 1 : idx < 6 ? 2 : 3; const int sb = idx - (lb * (lb + 1)) / 2;
#pragma unroll
                for (int r = 0; r < 16; ++r) Bm[(32 * lb + crow(r, hi)) * SP + 32 * sb + r32] = bf1(cb[q][r]);
            }
        }
        __syncthreads();
        {
            const int lb = wid >> 1, pb = wid & 1;
            f32x16 acc;
#pragma unroll
            for (int r = 0; r < 16; ++r) acc[r] = 0.f;
#pragma unroll
            for (int kk = 0; kk < 8; ++kk) { const bf16x8 af = *(const LAS bf16x8*)(Cm + (32 * lb + r32) * SP + 16 * kk + 8 * hi); const bf16x8 bfm = *(const LAS bf16x8*)(Sb + (32 * pb + r32) * SP + 16 * kk + 8 * hi); acc = MFMA32(af, bfm, acc); }
#pragma unroll
            for (int r = 0; r < 16; ++r) acc[r] *= eacs[32 * lb + crow(r, hi)];
            for (int sb = 0; sb <= lb; ++sb)
#pragma unroll
                for (int k2 = 0; k2 < 2; ++k2) { const bf16x8 af = *(const LAS bf16x8*)(Bm + (32 * lb + r32) * SP + 32 * sb + 16 * k2 + 8 * hi); const bf16x8 bfm = *(const LAS bf16x8*)(XT + (32 * pb + r32) * SP + ((32 * sb + 16 * k2 + 8 * hi) ^ (((32 * pb + r32) >> 3) << 3))); acc = MFMA32(af, bfm, acc); }
#pragma unroll
            for (int rg = 0; rg < 4; ++rg) { const int l = 32 * lb + 8 * rg + 4 * hi; const u32x2 xw = *(const LAS u32x2*)(XT + (32 * pb + r32) * SP + (l ^ (((32 * pb + r32) >> 3) << 3)));
                acc[4 * rg + 0] += ddt[l + 0] * bflo(xw.x); acc[4 * rg + 1] += ddt[l + 1] * bfhi(xw.x); acc[4 * rg + 2] += ddt[l + 2] * bflo(xw.y); acc[4 * rg + 3] += ddt[l + 3] * bfhi(xw.y); }
            unsigned short zr[16];
#pragma unroll
            for (int r = 0; r < 16; ++r) zr[r] = Z[(t0 + 32 * lb + crow(r, hi)) * 2048 + h * 64 + 32 * pb + r32];
#pragma unroll
            for (int r = 0; r < 16; ++r) { const float zv = bf2f(zr[r]); Z[(t0 + 32 * lb + crow(r, hi)) * 2048 + h * 64 + 32 * pb + r32] = bf1(acc[r] * zv * fsigm(zv)); }
        }
        {
            const int pb = wid >> 2, nb = wid & 3; const float etot = eacs[127];
#pragma unroll
            for (int r = 0; r < 16; ++r) S[r] *= etot;
#pragma unroll 2
            for (int kk = 0; kk < 8; ++kk) {
                const u32x4 xw = *(const LAS u32x4*)(XT + (32 * pb + r32) * SP + ((16 * kk + 8 * hi) ^ (((32 * pb + r32) >> 3) << 3))); const LAS float* dp = dec + 16 * kk + 8 * hi;
                u32x4 aw; aw.x = pk2(bflo(xw.x) * dp[0], bfhi(xw.x) * dp[1]); aw.y = pk2(bflo(xw.y) * dp[2], bfhi(xw.y) * dp[3]); aw.z = pk2(bflo(xw.z) * dp[4], bfhi(xw.z) * dp[5]); aw.w = pk2(bflo(xw.w) * dp[6], bfhi(xw.w) * dp[7]);
                const bf16x8 bfm = *(const LAS bf16x8*)(BT + (32 * nb + r32) * SP + ((16 * kk + 8 * hi) ^ (((32 * nb + r32) >> 3) << 3)));
                S = MFMA32(__builtin_bit_cast(bf16x8, aw), bfm, S);
            }
            __syncthreads();
#pragma unroll
            for (int r = 0; r < 16; ++r) Sb[(32 * pb + crow(r, hi)) * SP + 32 * nb + r32] = bf1(S[r]);
        }
    }
    __syncthreads();
}

struct PairOrder {
    pg8::StaticOrder base;
    __device__ __forceinline__ bool next(int i, pg8::Unit& u) const { if (!base.next(i >> 1, u)) return false; u.pn += 4 * (i & 1); return true; }
    __device__ __forceinline__ void a_ready(const pg8::Unit&) const {}
    __device__ __forceinline__ void done(const pg8::Unit&) const {}
};
#define XB_USE 1
typedef unsigned v4u_unused_t;
#define XB_TMO      128
#define XB_XCNT(j)  (256  + 64 * (j))
#define XB_XSUB(j)  (1280 + 64 * (j))
#define XB_XGEN(j)  (2304 + 64 * (j))
#define XB_TOP      3328
#define XB_TOPGEN   3392
#define XCD_BAR_WORDS 3456
#define XB_SPIN_CAP (1u << 18)

__device__ __forceinline__ unsigned xb_ld(unsigned* p)              { return __hip_atomic_load(p, __ATOMIC_RELAXED, __HIP_MEMORY_SCOPE_AGENT); }
__device__ __forceinline__ unsigned xb_add(unsigned* p, unsigned v) { return __hip_atomic_fetch_add(p, v, __ATOMIC_RELAXED, __HIP_MEMORY_SCOPE_AGENT); }
__device__ __forceinline__ unsigned xb_xcc_id() { return (unsigned)__builtin_amdgcn_s_getreg((3 << 11) | 20) & 0xFu; }
#define XB_SPIN(cond, bar) do { unsigned _sp = 0; while (cond) { __builtin_amdgcn_s_sleep(1); \
    if ((++_sp & 255u) == 0u) { if (xb_ld(&(bar)[XB_TMO])) break; if (_sp > XB_SPIN_CAP) { atomicAdd(&(bar)[XB_TMO], 1u); break; } } } } while (0)

struct XcdBarrier {
    unsigned* bar; unsigned x;
    volatile LAS unsigned* st;
};

__device__ __forceinline__ XcdBarrier xcd_barrier_post(unsigned* bar, volatile LAS unsigned* st) {
    XcdBarrier b; b.bar = bar; b.x = xb_xcc_id(); b.st = st;
    if (threadIdx.x == 0) (void)xb_add(&bar[XB_XCNT(b.x)], 1u);
    return b;
}
__device__ __forceinline__ void xcd_barrier_complete(unsigned* bar, unsigned x, unsigned& nloc, unsigned& nx) {
    const unsigned G = gridDim.x * gridDim.y * gridDim.z;
    unsigned sum, cnt, mine, sp = 0u;
    for (;;) {
        sum = 0u; cnt = 0u; mine = 0u;
#pragma unroll
        for (unsigned j = 0; j < 16; ++j) { const unsigned c = xb_ld(&bar[XB_XCNT(j)]); sum += c; cnt += (c > 0u) ? 1u : 0u; mine = (j == x) ? c : mine; }
        if (sum == G) break;
        __builtin_amdgcn_s_sleep(1);
        if ((++sp & 255u) == 0u) { if (xb_ld(&bar[XB_TMO])) break; if (sp > XB_SPIN_CAP) { atomicAdd(&bar[XB_TMO], 1u); break; } }
    }
    nloc = mine > 0u ? mine : 1u; nx = cnt > 0u ? cnt : 1u;
}

__device__ __forceinline__ void xcd_barrier(const XcdBarrier& b) {
    asm volatile("s_waitcnt vmcnt(0)" ::: "memory");
    __syncthreads();
    if (threadIdx.x == 0) {
        unsigned* bar = b.bar;
        __builtin_amdgcn_s_waitcnt(0);
        unsigned nloc = b.st[0], nx = b.st[1];
        if (nloc == 0u) { xcd_barrier_complete(bar, b.x, nloc, nx); b.st[0] = nloc; b.st[1] = nx; }
        const unsigned old = xb_add(&bar[XB_XSUB(b.x)], 1u);
        const unsigned gen = old / nloc;
        if (old + 1u == (gen + 1u) * nloc) {
            __builtin_amdgcn_fence(__ATOMIC_RELEASE, "agent");
            asm volatile("s_waitcnt vmcnt(0)" ::: "memory");
            const unsigned og = xb_add(&bar[XB_TOP], 1u);
            const unsigned tg = og / nx;
            if (og + 1u == (tg + 1u) * nx) xb_add(&bar[XB_TOPGEN], 1u);
            else XB_SPIN(xb_ld(&bar[XB_TOPGEN]) == tg, bar);
            __builtin_amdgcn_fence(__ATOMIC_ACQUIRE, "agent");
            xb_add(&bar[XB_XGEN(b.x)], 1u);
            asm volatile("s_waitcnt vmcnt(0)" ::: "memory");
        } else {
            XB_SPIN(xb_ld(&bar[XB_XGEN(b.x)]) == gen, bar);
            __builtin_amdgcn_fence(__ATOMIC_ACQUIRE, "agent");
            asm volatile("s_waitcnt vmcnt(0)" ::: "memory");
        }
    }
    __syncthreads();
}

struct Args { const float* in[34]; float* out; unsigned char* ws; int ph_lo, ph_hi; };
constexpr int N_PHASES = 19;

__global__ void __launch_bounds__(NTHREADS, 2) mk_fwd(Args a) {
    extern __shared__ __attribute__((aligned(16))) unsigned char lds_raw[];
    LAS unsigned char* lds = (LAS unsigned char*)lds_raw;
    cg::grid_group grid = cg::this_grid();
    { volatile LAS unsigned* xst = (volatile LAS unsigned*)(lds + 155632);
      if (threadIdx.x == 0) { xst[0] = 0u; xst[1] = 0u; }
      __syncthreads();
      (void)xcd_barrier_post((unsigned*)(a.ws + 8192), xst); }
    grid.sync();
    const int G = gridDim.x, bx = blockIdx.x;
#define PH_IDS int tid; asm volatile("v_mov_b32 %0, %1" : "=v"(tid) : "v"(threadIdx.x)); const int lane = tid & 63, wid = __builtin_amdgcn_readfirstlane(tid >> 6); \
    const int vcu = (G % 8 == 0) ? (bx % 8) * (G / 8) + bx / 8 : bx; const int gw = vcu * NWAVES + wid, NGW = G * NWAVES; (void)lane; (void)gw; (void)NGW; \
    LAS float* scr = (LAS float*)(lds + wid * 16384); (void)scr; \
    const float* const* INP; { const void* kp_ = (const void*)__builtin_amdgcn_kernarg_segment_ptr(); asm volatile("" : "=s"(INP) : "0"(kp_)); } (void)INP;
    unsigned char* ws = a.ws;
    float* out = a.out; bf16_t* RB = (bf16_t*)a.out + (size_t)T_ * DM_;
    bf16_t* ABUF = (bf16_t*)(ws + WS_ABUF);
#define IN(k) (a.ph_lo <= (k) && (k) < a.ph_hi)
#define GSYNC_W(woff_, target_) do { XcdBarrier xb_; xb_.bar = (unsigned*)(a.ws + 8192); xb_.x = xb_xcc_id(); xb_.st = (volatile LAS unsigned*)(lds + 155632); \
    asm volatile("s_waitcnt vmcnt(0) lgkmcnt(0)" ::: "memory"); xcd_barrier(xb_); } while (0)
#define GSYNC(k) GSYNC_W(0, (k) + 1 - a.ph_lo - (((k) > 12 && a.ph_lo <= 12) ? 1 : 0))
#define SEAM(k) do { if (a.ph_lo <= (k) && (k) + 1 < a.ph_hi) GSYNC(k); } while (0)
    using namespace pg8;

    if (IN(0)) { PH_IDS
        int itb = 0;
        tr_job(INP[4], DM_, 2 * DFF_, 0, 2 * DFF_, (bf16_t*)(ws + WS_WGU), 1, scr, gw, NGW, lane, itb);
        if (G < 256) tr_job(INP[5], DFF_, DM_, 0, DM_, (bf16_t*)(ws + WS_WD), 0, scr, gw, NGW, lane, itb);
        tr_job(INP[8], DM_, 10272, 0, 8224, (bf16_t*)(ws + WS_WIN), 0, scr, gw, NGW, lane, itb);
        tr_job(INP[28], DM_, 2048, 0, 2048, (bf16_t*)(ws + WS_WKV), 0, scr, gw, NGW, lane, itb);
        rowwise<false, false>(nullptr, INP[0], nullptr, 0.f, nullptr, INP[2], ABUF, T_, gw, NGW, lane);
        rowwise<false, false>(nullptr, INP[1], nullptr, 0.f, nullptr, INP[26], (bf16_t*)(ws + WS_MEMN), MEMT_, gw, NGW, lane);
    }
    SEAM(0);
    if (IN(1)) { PH_IDS
        { Gemm g{ABUF, (const bf16_t*)(ws + WS_WGU), T_, 2 * DFF_, DM_}; StaticOrder S; S.init(T_, 2 * DFF_, G, bx); EpiSwiglu E{(bf16_t*)(ws + WS_HBUF), DFF_};
          gemm_phase<EpiSwiglu, StaticOrder, true, true>(lds, g, S, E); }
        { Gemm g{(const bf16_t*)(ws + WS_MEMN), (const bf16_t*)(ws + WS_WKV), MEMT_, 1024, DM_}; StaticOrder S; S.init(MEMT_, 1024, G, (bx + 112) % G); EpiB<0> E{(bf16_t*)(ws + WS_KX), 1024, nullptr, 0, 0};
          gemm_phase<EpiB<0>, StaticOrder, false, true>(lds, g, S, E); }
        { Gemm g{(const bf16_t*)(ws + WS_WKV) + (size_t)1024 * 1024, (const bf16_t*)(ws + WS_MEMN), 1024, MEMT_, DM_}; StaticOrder S; S.init(1024, MEMT_, G, (bx + 128) % G); EpiB<0> E{(bf16_t*)(ws + WS_VXT), MEMT_, nullptr, 0, 0};
          gemm_phase<EpiB<0>, StaticOrder, false, true>(lds, g, S, E); }
            if (G >= 256 && bx >= 128) {
            int tid2; asm volatile("v_mov_b32 %0, %1" : "=v"(tid2) : "v"(threadIdx.x)); const int lane2 = tid2 & 63, wid2 = __builtin_amdgcn_readfirstlane(tid2 >> 6);
            int itb2 = 0; tr_job(INP[5], DFF_, DM_, 0, DM_, (bf16_t*)(ws + WS_WD), 0, (LAS float*)(lds + wid2 * 16384), (bx - 128) * NWAVES + wid2, (G - 128) * NWAVES, lane2, itb2);
        }
    }
    SEAM(1);
    if (IN(2)) { PH_IDS
        Gemm g{(const bf16_t*)(ws + WS_HBUF), (const bf16_t*)(ws + WS_WD), T_, DM_, DFF_}; StaticOrder S; S.init(T_, DM_, G, bx); EpiB<0> E{(bf16_t*)(ws + WS_YBUF_A), DM_, nullptr, 0, 0};
        gemm_phase<EpiB<0>, StaticOrder, false, true>(lds, g, S, E);
    }
    SEAM(2);
    if (IN(3)) { PH_IDS rowwise<false, true>((const bf16_t*)(ws + WS_YBUF_A), INP[0], INP[3], 0.5f, RB, INP[6], ABUF, T_, gw, NGW, lane); }
    SEAM(3);
    if (IN(4)) { PH_IDS
        { Gemm g{ABUF, (const bf16_t*)(ws + WS_WIN), T_, 2048, DM_}; StaticOrder S; S.init(T_, 2048, G, bx); EpiB<0> E{(bf16_t*)(ws + WS_Q), 1024, nullptr, 1024, (WS_K - WS_Q) / 2};
          gemm_phase<EpiB<0>, StaticOrder, true, true>(lds, g, S, E); }
        { Gemm g{(const bf16_t*)(ws + WS_WIN) + (size_t)2048 * 1024, ABUF, 1024, T_, DM_}; StaticOrder S; S.init(1024, T_, G, bx); EpiB<0> E{(bf16_t*)(ws + WS_VT), T_, nullptr, 0, 0};
          gemm_phase<EpiB<0>, StaticOrder, false, true>(lds, g, S, E); }
    }
    SEAM(4);
    if (IN(5)) { PH_IDS
        const float v1 = INP[10][lane] * INP[11][lane], v2 = INP[12][lane] * INP[13][lane];
        const float lam = __expf(wave_sum(v1)) - __expf(wave_sum(v2)) + 0.2f;
        for (int u = vcu; u < 512; u += G) {
            const int v = u & 255, bh = v >> 3, qb = u < 256 ? (v & 7) : 15 - (v & 7);
            diffattn_unit(bh >> 3, bh & 7, qb, (const bf16_t*)(ws + WS_Q), (const bf16_t*)(ws + WS_K), (const bf16_t*)(ws + WS_VT), (bf16_t*)(ws + WS_Q), lam, INP[14], lds, wid, lane);
        }
    }
    SEAM(5);
    if (IN(6)) { PH_IDS
        Gemm g{ABUF, (const bf16_t*)(ws + WS_WIN) + (size_t)3072 * 1024, T_, 5120, DM_}; StaticOrder S; S.init(T_, 5120, G, bx);
        EpiInB E{(bf16_t*)(ws + WS_Z), (bf16_t*)(ws + WS_XS), (bf16_t*)(ws + WS_BC), (float*)(ws + WS_DTT), INP[17], T_};
        gemm_phase<EpiInB, StaticOrder, true, true>(lds, g, S, E);
        if (gw < T_ / 32) {
            const int r32 = lane & 31, hi = lane >> 5; const size_t row0 = (size_t)gw * 32;
            const bf16_t* ap = ABUF + (row0 + r32) * DM_ + 8 * hi; const bf16_t* bp = (const bf16_t*)(ws + WS_WIN) + (size_t)(8192 + r32) * 1024 + 8 * hi;
            f32x16 acc;
#pragma unroll
            for (int r = 0; r < 16; ++r) acc[r] = 0.f;
#pragma unroll 8
            for (int kk = 0; kk < 64; ++kk) acc = MFMA32(*(const bf16x8*)(ap + 16 * kk), *(const bf16x8*)(bp + 16 * kk), acc);
            const float bias = INP[17][r32]; float* dtT = (float*)(ws + WS_DTT);
#pragma unroll
            for (int r = 0; r < 16; ++r) { const float xv = acc[r] + bias; dtT[(size_t)r32 * T_ + row0 + crow(r, hi)] = xv > 20.f ? xv : log1pf(__expf(xv)); }
        }
        GSYNC_W(32, 1);
        { const int gt = gw * 64 + lane, cg = gt & 127, run = gt >> 7; bf16_t* base = (bf16_t*)(ws + WS_BC) + (size_t)run * 16 * 1024 + cg * 8;
          u32x4 rw[19];
#pragma unroll
          for (int j = 0; j < 3; ++j) rw[j] = ((run * 16) % SEQ_ == 0) ? (u32x4){0u, 0u, 0u, 0u} : *(const u32x4*)(base - (size_t)(3 - j) * 1024);
          GSYNC_W(32, 2);
#pragma unroll
          for (int j = 0; j < 16; ++j) rw[3 + j] = *(const u32x4*)(base + (size_t)j * 1024);
          float wv[8][5];
#pragma unroll
          for (int k = 0; k < 8; ++k) {
#pragma unroll
              for (int j = 0; j < 4; ++j) wv[k][j] = INP[15][j * 3072 + 2048 + cg * 8 + k];
              wv[k][4] = INP[16][2048 + cg * 8 + k]; }
#pragma unroll
          for (int i = 0; i < 16; ++i) { float o[8];
#pragma unroll
              for (int k = 0; k < 8; ++k) { float acc = wv[k][4];
#pragma unroll
                  for (int j = 0; j < 4; ++j) { const u32x4 r4 = rw[i + j]; const unsigned w = (k >> 1) == 0 ? r4.x : (k >> 1) == 1 ? r4.y : (k >> 1) == 2 ? r4.z : r4.w; acc += wv[k][j] * ((k & 1) ? bfhi(w) : bflo(w)); }
                  o[k] = acc * fsigm(acc); }
              u32x4 ov; ov.x = pk2(o[0], o[1]); ov.y = pk2(o[2], o[3]); ov.z = pk2(o[4], o[5]); ov.w = pk2(o[6], o[7]);
              *(u32x4*)(base + (size_t)i * 1024) = ov; }
        }
    }
    SEAM(6);
    if (IN(7)) { PH_IDS
        const int ssd_u = (G >= 256) ? (((vcu & 31) < 16) ? (vcu >> 5) * 16 + (vcu & 31) : 128) : vcu;
        for (int u = ssd_u; u < 128; u += G)
            ssd_unit(u >> 5, u & 31, (const bf16_t*)(ws + WS_XS), (const bf16_t*)(ws + WS_BC), (bf16_t*)(ws + WS_Z), (const float*)(ws + WS_DTT), INP[15], INP[16], INP[18], INP[19], lds, wid, lane);
            if (G >= 256 && (vcu & 31) >= 16) {
            int tid2; asm volatile("v_mov_b32 %0, %1" : "=v"(tid2) : "v"(threadIdx.x)); const int lane = tid2 & 63;
            const int gw2 = ((vcu >> 5) * 16 + (vcu & 31) - 16) * NWAVES + wid, NGW2 = (G - 128) * NWAVES; int itb = 0;
            tr_job(INP[8], DM_, 10272, 8224, 2048, (bf16_t*)(ws + WS_WG), 0, scr, gw2, NGW2, lane, itb);
            tr_job(INP[21], DM_, DM_, 0, DM_, (bf16_t*)(ws + WS_WBA), 0, scr, gw2, NGW2, lane, itb);
            tr_job(INP[22], 2048, DM_, 0, DM_, (bf16_t*)(ws + WS_WBS), 0, scr, gw2, NGW2, lane, itb);
            tr_job(INP[23], DM_, DM_, 0, DM_, (bf16_t*)(ws + WS_WMO), 0, scr, gw2, NGW2, lane, itb);
            tr_job(INP[27], DM_, DM_, 0, DM_, (bf16_t*)(ws + WS_WQ), 0, scr, gw2, NGW2, lane, itb);
            tr_job(INP[29], DM_, DM_, 0, DM_, (bf16_t*)(ws + WS_WO), 0, scr, gw2, NGW2, lane, itb);
        }
    }
    SEAM(7);
    if (IN(8)) { PH_IDS
        groupnorm_rows((bf16_t*)(ws + WS_Z), INP[20], T_, gw, NGW, lane);
        if (G < 256) { int itb = 0;
        tr_job(INP[8], DM_, 10272, 8224, 2048, (bf16_t*)(ws + WS_WG), 0, scr, gw, NGW, lane, itb);
        tr_job(INP[21], DM_, DM_, 0, DM_, (bf16_t*)(ws + WS_WBA), 0, scr, gw, NGW, lane, itb);
        tr_job(INP[22], 2048, DM_, 0, DM_, (bf16_t*)(ws + WS_WBS), 0, scr, gw, NGW, lane, itb);
        tr_job(INP[23], DM_, DM_, 0, DM_, (bf16_t*)(ws + WS_WMO), 0, scr, gw, NGW, lane, itb);
        tr_job(INP[27], DM_, DM_, 0, DM_, (bf16_t*)(ws + WS_WQ), 0, scr, gw, NGW, lane, itb);
        tr_job(INP[29], DM_, DM_, 0, DM_, (bf16_t*)(ws + WS_WO), 0, scr, gw, NGW, lane, itb); }
    }
    SEAM(8);
    if (IN(9)) { PH_IDS
        { Gemm g{ABUF, (const bf16_t*)(ws + WS_WG), T_, 2048, DM_}; PairOrder S; S.base.init(T_, DM_, G, bx); EpiB<0> E{(bf16_t*)(ws + WS_GA), 1024, nullptr, 1024, (WS_GS - WS_GA) / 2};
          gemm_phase<EpiB<0>, PairOrder, true, true>(lds, g, S, E); }
        { Gemm g{(const bf16_t*)(ws + WS_Q), (const bf16_t*)(ws + WS_WBA), T_, DM_, DM_}; StaticOrder S; S.init(T_, DM_, G, bx); EpiBranch<false> E{(const bf16_t*)(ws + WS_GA), nullptr, (bf16_t*)(ws + WS_TMP), INP[9]};
          gemm_phase<EpiBranch<false>, StaticOrder, false, true>(lds, g, S, E); }
        { Gemm g{(const bf16_t*)(ws + WS_Z), (const bf16_t*)(ws + WS_WBS), T_, DM_, 2048}; StaticOrder S; S.init(T_, DM_, G, bx); EpiBranch<true> E{(const bf16_t*)(ws + WS_GS), (const bf16_t*)(ws + WS_TMP), (bf16_t*)(ws + WS_GA), INP[9] + 1024};
          gemm_phase<EpiBranch<true>, StaticOrder, false, true>(lds, g, S, E); }
    }
    SEAM(9);
    if (IN(10)) { PH_IDS
        Gemm g{(const bf16_t*)(ws + WS_GA), (const bf16_t*)(ws + WS_WMO), T_, DM_, DM_}; StaticOrder S; S.init(T_, DM_, G, bx); EpiB<0> E{(bf16_t*)(ws + WS_YBUF_B), DM_, nullptr, 0, 0};
        gemm_phase<EpiB<0>, StaticOrder, false, true>(lds, g, S, E);
    }
    SEAM(10);
    if (IN(11)) { PH_IDS
        rowwise<true, true>((const bf16_t*)(ws + WS_YBUF_B), RB, INP[7], 1.0f, RB, INP[24], ABUF, T_, gw, NGW, lane);
        int itb = 0;
        tr_job(INP[32], DM_, 2 * DFF_, 0, 2 * DFF_, (bf16_t*)(ws + WS_WGU), 1, scr, gw, NGW, lane, itb);
        if (G < 256) tr_job(INP[33], DFF_, DM_, 0, DM_, (bf16_t*)(ws + WS_WD), 0, scr, gw, NGW, lane, itb);
    }
    SEAM(11);
    if (IN(12)) { PH_IDS
        Gemm g{ABUF, (const bf16_t*)(ws + WS_WQ), T_, DM_, DM_}; StaticOrder S; S.init(T_, DM_, G, bx); EpiB<0> E{(bf16_t*)(ws + WS_QX), 1024, nullptr, 0, 0};
        gemm_phase<EpiB<0>, StaticOrder, false, true>(lds, g, S, E);
        asm volatile("s_waitcnt vmcnt(0) lgkmcnt(0)" ::: "memory"); __syncthreads();
        Unit u;
        for (int i = 0; S.next(i, u); ++i)
            for (int dh = 0; dh < 2; ++dh)
                xattn_unit(u.pm >> 4, u.pn, u.pm & 15, dh, (const bf16_t*)(ws + WS_QX), (const bf16_t*)(ws + WS_KX), (const bf16_t*)(ws + WS_VXT), (bf16_t*)(ws + WS_XO), lds, wid, lane);
    }
    SEAM(13);
    if (IN(14)) { PH_IDS
        Gemm g{(const bf16_t*)(ws + WS_XO), (const bf16_t*)(ws + WS_WO), T_, DM_, DM_}; StaticOrder S; S.init(T_, DM_, G, bx); EpiB<0> E{(bf16_t*)(ws + WS_YBUF_B), DM_, nullptr, 0, 0};
        gemm_phase<EpiB<0>, StaticOrder, false, true>(lds, g, S, E);
    }
    SEAM(14);
    if (IN(15)) { PH_IDS rowwise<true, true>((const bf16_t*)(ws + WS_YBUF_B), RB, INP[25], 1.0f, RB, INP[30], ABUF, T_, gw, NGW, lane); }
    SEAM(15);
    if (IN(16)) { PH_IDS
        Gemm g{ABUF, (const bf16_t*)(ws + WS_WGU), T_, 2 * DFF_, DM_}; StaticOrder S; S.init(T_, 2 * DFF_, G, bx); EpiSwiglu E{(bf16_t*)(ws + WS_HBUF), DFF_};
        gemm_phase<EpiSwiglu, StaticOrder, true, true>(lds, g, S, E);
            if (G >= 256 && bx >= 128) {
            int tid2; asm volatile("v_mov_b32 %0, %1" : "=v"(tid2) : "v"(threadIdx.x)); const int lane2 = tid2 & 63, wid2 = __builtin_amdgcn_readfirstlane(tid2 >> 6);
            int itb2 = 0; tr_job(INP[33], DFF_, DM_, 0, DM_, (bf16_t*)(ws + WS_WD), 0, (LAS float*)(lds + wid2 * 16384), (bx - 128) * NWAVES + wid2, (G - 128) * NWAVES, lane2, itb2);
        }
    }
    SEAM(16);
    if (IN(17)) { PH_IDS
        Gemm g{(const bf16_t*)(ws + WS_HBUF), (const bf16_t*)(ws + WS_WD), T_, DM_, DFF_}; StaticOrder S; S.init(T_, DM_, G, bx); EpiB<0> E{(bf16_t*)(ws + WS_YBUF_A), DM_, nullptr, 0, 0};
        gemm_phase<EpiB<0>, StaticOrder, false, true>(lds, g, S, E);
    }
    SEAM(17);
    if (IN(18)) { PH_IDS
        f32x4 res[8][4];
#pragma unroll
        for (int i = 0; i < 8; ++i) { const size_t m = (size_t)gw * 8 + i; load_row<true>(res[i], RB, m, lane); add_normed(res[i], (const bf16_t*)(ws + WS_YBUF_A), m, INP[31], 0.5f, lane); }
        GSYNC_W(32, 3);
#pragma unroll
        for (int i = 0; i < 8; ++i) { f32x4* o = (f32x4*)(out + ((size_t)gw * 8 + i) * DM_) + lane;
#pragma unroll
            for (int j = 0; j < 4; ++j) __builtin_nontemporal_store(res[i][j], o + 64 * j); }
    }
#undef IN
#undef SEAM
}

#ifndef MK_PER_PHASE
#define MK_PER_PHASE 0
#endif
extern "C" void kernel_launch(void* const* d_in, const int* in_sizes, int n_in, void* d_out, int out_size, void* d_ws, size_t ws_size, hipStream_t stream) {
    static int grid = 0;
    if (grid == 0) {
        if (n_in != 34 || out_size != T_ * DM_ || ws_size < WS_NEED) { fprintf(stderr, "kernel_launch: unexpected shapes (n_in %d, out %d, ws %zu); nothing launched\n", n_in, out_size, ws_size); grid = -1; return; }
        int dev = 0, cus = 0, per_cu = 0;
        if (hipGetDevice(&dev) != hipSuccess || hipDeviceGetAttribute(&cus, hipDeviceAttributeMultiprocessorCount, dev) != hipSuccess) { grid = -1; return; }
        if (hipFuncSetAttribute((const void*)mk_fwd, hipFuncAttributeMaxDynamicSharedMemorySize, LDS_BYTES) != hipSuccess) { fprintf(stderr, "kernel_launch: hipFuncSetAttribute failed\n"); grid = -1; return; }
        if (hipOccupancyMaxActiveBlocksPerMultiprocessor(&per_cu, (const void*)mk_fwd, NTHREADS, LDS_BYTES) != hipSuccess || per_cu < 1) { fprintf(stderr, "kernel_launch: occupancy query says %d blocks per CU\n", per_cu); (void)hipGetLastError(); grid = -1; return; }
        if (cus != 256) { fprintf(stderr, "kernel_launch: built for a 256-CU device (the final phase deals 8 rows to each of 2048 waves); found %d CUs, nothing launched\n", cus); grid = -1; return; }
        grid = cus;
    }
    if (grid < 0) return;
    (void)hipMemsetAsync((char*)d_ws + 8192, 0, 16384, stream);
    Args a{};
    for (int i = 0; i < 34; ++i) a.in[i] = (const float*)d_in[i];
    a.out = (float*)d_out; a.ws = (unsigned char*)d_ws;
#if MK_PER_PHASE
    for (int p = 0; p < N_PHASES; ++p) {
        a.ph_lo = p; a.ph_hi = p + 1;
        void* args[] = {&a};
        hipError_t e = hipLaunchCooperativeKernel((const void*)mk_fwd, dim3(grid), dim3(NTHREADS), args, LDS_BYTES, stream);
        if (e != hipSuccess) { fprintf(stderr, "launch %d failed: %s\n", p, hipGetErrorString(e)); break; }
    }
#else
    a.ph_lo = 0; a.ph_hi = N_PHASES;
    void* args[] = {&a};
    hipError_t e = hipLaunchCooperativeKernel((const void*)mk_fwd, dim3(grid), dim3(NTHREADS), args, LDS_BYTES, stream);
    if (e != hipSuccess) fprintf(stderr, "cooperative launch failed: %s (grid %d)\n", hipGetErrorString(e), grid);
#endif
}
```
